# Optimizing an MI355X kernel written in HIP

```python
import jax, jax.numpy as jnp
from jax import lax
import numpy as np


D_MODEL = 2048
BATCH = 8
SEQ = 2048
DEPTH = 2

A_HEADS = 16
A_HEAD_DIM = 128
A_KV_RANK = 256
IDX_HEADS = 16
IDX_DIM = 64
TOPK_MAX = 256
Q_BLOCK = 128
M_HEADS = 8
M_QK_DIM = 128
M_V_DIM = 256
M_CHUNK = 64
N_GROUPS = 4
EXPERTS_PER_GROUP = 4
N_EXPERTS = N_GROUPS * EXPERTS_PER_GROUP
TOP_K_IN_GROUP = 2
EXPERT_FF = 512
PLE_DIM = 256
LN_EPS = 1e-5
DN_ALPHA = (2 * DEPTH) ** 0.25
DN_BETA = (8 * DEPTH) ** -0.25

_SPLITS = (
    ('a_q', A_HEADS * A_HEAD_DIM),
    ('a_ckv', A_KV_RANK),
    ('i_q', IDX_HEADS * IDX_DIM),
    ('i_k', IDX_DIM),
    ('i_w', IDX_HEADS),
    ('m_q', M_HEADS * M_QK_DIM),
    ('m_k', M_HEADS * M_QK_DIM),
    ('m_v', M_HEADS * M_V_DIM),
    ('m_o', M_HEADS * M_V_DIM),
    ('m_i', M_HEADS),
    ('m_f', M_HEADS),
    ('g_a', D_MODEL),
    ('g_m', D_MODEL),
)
IN_WIDTH = sum(n for _, n in _SPLITS)

kernel_name = 'hybrid_dsa_mlstm_hmoe_deepnorm'

F32 = jnp.float32


def _split_cols(a):
    offs = np.cumsum([n for _, n in _SPLITS])[:-1].tolist()
    return jnp.split(a, offs, axis=-1)


def layer_norm(x, g, b):
    xf = x.astype(F32)
    mu = jnp.mean(xf, -1, keepdims=True)
    var = jnp.mean(jnp.square(xf - mu), -1, keepdims=True)
    return ((xf - mu) * lax.rsqrt(var + LN_EPS) * g.astype(F32) + b.astype(F32)).astype(x.dtype)


def rms_norm(x, g):
    xf = x.astype(F32)
    return (xf * lax.rsqrt(jnp.mean(jnp.square(xf), -1, keepdims=True) + LN_EPS) * g.astype(F32)).astype(x.dtype)


def alibi_slopes(n):
    return jnp.exp2(-8.0 * jnp.arange(1, n + 1, dtype=F32) / n)


def dsa_attention(q, kv, iq, ik, iw):
    B, S = q.shape[0], q.shape[1]
    n_keep = min(TOPK_MAX, S // 4)
    n_blocks = S // Q_BLOCK
    slopes = alibi_slopes(A_HEADS)
    key_pos = jnp.arange(S)
    ikf = ik.astype(F32)

    def block(i):
        t0 = i * Q_BLOCK
        qb = lax.dynamic_slice_in_dim(q, t0, Q_BLOCK, axis=1).astype(F32)
        iqb = lax.dynamic_slice_in_dim(iq, t0, Q_BLOCK, axis=1).astype(F32)
        iwb = lax.dynamic_slice_in_dim(iw, t0, Q_BLOCK, axis=1).astype(F32)
        qpos = t0 + jnp.arange(Q_BLOCK)
        rel = jax.nn.relu(jnp.einsum('bqhd,bsd->bqhs', iqb, ikf) * IDX_DIM ** -0.5)
        score = jnp.einsum('bqh,bqhs->bqs', iwb * IDX_HEADS ** -0.5, rel)
        causal = key_pos[None, :] <= qpos[:, None]
        score = jnp.where(causal[None], score, -jnp.inf)
        _, sel = lax.top_k(score, n_keep)
        kv_sel = jax.vmap(lambda kvb, ib: kvb[ib])(kv, sel).astype(F32)
        k_sel, v_sel = kv_sel[..., :A_HEAD_DIM], kv_sel[..., A_HEAD_DIM:]
        logits = jnp.einsum('bqhd,bqnd->bqhn', qb, k_sel) * A_HEAD_DIM ** -0.5
        dist = (qpos[None, :, None] - sel).astype(F32)
        logits = logits - slopes[None, None, :, None] * dist[:, :, None, :]
        valid = sel <= qpos[None, :, None]
        logits = jnp.where(valid[:, :, None, :], logits, -jnp.inf)
        probs = jax.nn.softmax(logits, axis=-1)
        return jnp.einsum('bqhn,bqnd->bqhd', probs, v_sel).astype(q.dtype)

    out = lax.map(block, jnp.arange(n_blocks))
    return out.transpose(1, 0, 2, 3, 4).reshape(B, S, A_HEADS * A_HEAD_DIM)


def mlstm(q, k, v, i_pre, f_pre):
    B, S, H, dk = q.shape
    dv = v.shape[-1]
    L = M_CHUNK
    nc = S // L

    def chunks(a):
        return a.astype(F32).reshape(B, nc, L, H, -1).transpose(0, 3, 1, 2, 4)

    def gchunks(a):
        return a.astype(F32).reshape(B, nc, L, H).transpose(0, 3, 1, 2)

    qc = chunks(q) * dk ** -0.5
    kc = chunks(k)
    vc = chunks(v)
    li = gchunks(i_pre)
    lf = jax.nn.log_sigmoid(gchunks(f_pre))
    bcum = jnp.cumsum(lf, axis=-1)
    b_last = bcum[..., -1]
    tri = jnp.tril(jnp.ones((L, L), dtype=bool))
    dmat = jnp.where(tri, bcum[..., :, None] - bcum[..., None, :] + li[..., None, :], -jnp.inf)
    w_end = b_last[..., None] - bcum + li
    a_end = jnp.max(w_end, axis=-1)
    kw = kc * jnp.exp(w_end - a_end[..., None])[..., None]

    def step(carry, xs):
        C, n, m = carry
        q_c, kw_c, v_c, a_c, bl_c = xs
        inter_num = jnp.einsum('bhlk,bhkv->bhlv', q_c, C)
        inter_den = jnp.einsum('bhlk,bhk->bhl', q_c, n)
        m_new = jnp.maximum(bl_c + m, a_c)
        decay = jnp.exp(bl_c + m - m_new)
        scale = jnp.exp(a_c - m_new)
        C_new = decay[..., None, None] * C + scale[..., None, None] * jnp.einsum('bhlk,bhlv->bhkv', kw_c, v_c)
        n_new = decay[..., None] * n + scale[..., None] * jnp.sum(kw_c, axis=-2)
        return (C_new, n_new, m_new), (inter_num, inter_den, m)

    init = (jnp.zeros((B, H, dk, dv), F32), jnp.zeros((B, H, dk), F32), jnp.zeros((B, H), F32))
    xs = (jnp.moveaxis(qc, 2, 0), jnp.moveaxis(kw, 2, 0), jnp.moveaxis(vc, 2, 0),
          jnp.moveaxis(a_end, 2, 0), jnp.moveaxis(b_last, 2, 0))
    _, (inter_num, inter_den, m_prev) = lax.scan(step, init, xs)
    inter_num = jnp.moveaxis(inter_num, 0, 2)
    inter_den = jnp.moveaxis(inter_den, 0, 2)
    m_prev = jnp.moveaxis(m_prev, 0, -1)

    inter_log = bcum + m_prev[..., None]
    m_row = jnp.maximum(inter_log, jnp.max(dmat, axis=-1))
    inter_w = jnp.exp(inter_log - m_row)
    intra_w = jnp.exp(dmat - m_row[..., None]) * jnp.einsum('bhcjk,bhcsk->bhcjs', qc, kc)
    num = inter_w[..., None] * inter_num + jnp.einsum('bhcjs,bhcsv->bhcjv', intra_w, vc)
    den = inter_w * inter_den + jnp.sum(intra_w, axis=-1)
    h = num / jnp.maximum(jnp.abs(den), jnp.exp(-m_row))[..., None]
    return h.transpose(0, 2, 3, 1, 4).reshape(B, S, H * dv)


def hier_moe(x, w_grp, b_grp, w_exp, b_exp, w_gate, w_up, w_down):
    B, S, D = x.shape
    xt = x.reshape(-1, D)
    xf = xt.astype(F32)
    grp_prob = jax.nn.softmax(xf @ w_grp.astype(F32) + b_grp.astype(F32), axis=-1)
    g_p, g_idx = lax.top_k(grp_prob, 1)
    exp_logits = (xf @ w_exp.astype(F32) + b_exp.astype(F32)).reshape(-1, N_GROUPS, EXPERTS_PER_GROUP)
    in_grp = jnp.take_along_axis(exp_logits, g_idx[:, :, None], axis=1)[:, 0]
    e_prob = jax.nn.softmax(in_grp, axis=-1)
    e_p, e_idx = lax.top_k(e_prob, TOP_K_IN_GROUP)
    e_p = e_p / jnp.sum(e_p, axis=-1, keepdims=True)
    w_in_grp = jnp.einsum('tk,tke->te', e_p, jax.nn.one_hot(e_idx, EXPERTS_PER_GROUP, dtype=F32))
    combine = (g_p[:, :, None] * jax.nn.one_hot(g_idx[:, 0], N_GROUPS, dtype=F32)[:, :, None]
               * w_in_grp[:, None, :]).reshape(-1, N_EXPERTS)
    hg = jnp.einsum('td,edf->tef', xt, w_gate)
    hu = jnp.einsum('td,edf->tef', xt, w_up)
    h = jax.nn.silu(hg) * hu * combine[:, :, None].astype(hg.dtype)
    return jnp.einsum('tef,efd->td', h, w_down).reshape(B, S, D)


def setup_inputs(seed: int = 0) -> dict:
    key = jax.random.key(seed)
    ks = jax.random.split(key, 24)

    def w(k, shape, fan_in, scale=1.0):
        return jax.random.normal(k, shape, F32) * (scale * fan_in ** -0.5)

    def noise(k, shape, s):
        return jax.random.normal(k, shape, F32) * s

    return {
        'x': jax.random.normal(ks[0], (BATCH, SEQ, D_MODEL), F32),
        'p': jax.random.normal(ks[1], (DEPTH, BATCH, SEQ, PLE_DIM), F32),
        'w_in': w(ks[2], (DEPTH, D_MODEL, IN_WIDTH), D_MODEL),
        'kv_norm': 1.0 + noise(ks[3], (DEPTH, A_KV_RANK), 0.02),
        'w_ukv': w(ks[4], (DEPTH, A_KV_RANK, 2 * A_HEAD_DIM), A_KV_RANK),
        'm_i_bias': noise(ks[5], (DEPTH, M_HEADS), 0.1),
        'm_f_bias': 3.0 + noise(ks[6], (DEPTH, M_HEADS), 0.5),
        'w_proj_a': w(ks[7], (DEPTH, A_HEADS * A_HEAD_DIM, D_MODEL), A_HEADS * A_HEAD_DIM),
        'w_proj_m': w(ks[8], (DEPTH, M_HEADS * M_V_DIM, D_MODEL), M_HEADS * M_V_DIM),
        'w_out': w(ks[9], (DEPTH, D_MODEL, D_MODEL), D_MODEL, DN_BETA),
        'ln1_g': 1.0 + noise(ks[10], (DEPTH, D_MODEL), 0.02),
        'ln1_b': noise(ks[11], (DEPTH, D_MODEL), 0.02),
        'w_grp': w(ks[12], (DEPTH, D_MODEL, N_GROUPS), D_MODEL),
        'b_grp': noise(ks[13], (DEPTH, N_GROUPS), 0.01),
        'w_exp': w(ks[14], (DEPTH, D_MODEL, N_EXPERTS), D_MODEL),
        'b_exp': noise(ks[15], (DEPTH, N_EXPERTS), 0.01),
        'w_gate': w(ks[16], (DEPTH, N_EXPERTS, D_MODEL, EXPERT_FF), D_MODEL),
        'w_up': w(ks[17], (DEPTH, N_EXPERTS, D_MODEL, EXPERT_FF), D_MODEL),
        'w_down': w(ks[18], (DEPTH, N_EXPERTS, EXPERT_FF, D_MODEL), EXPERT_FF, DN_BETA),
        'w_ple': w(ks[19], (DEPTH, PLE_DIM, D_MODEL), PLE_DIM, DN_BETA),
        'w_ple_gate': w(ks[20], (DEPTH, D_MODEL, D_MODEL), D_MODEL),
        'ln2_g': 1.0 + noise(ks[21], (DEPTH, D_MODEL), 0.02),
        'ln2_b': noise(ks[22], (DEPTH, D_MODEL), 0.02),
    }


def reference(x, p, w_in, kv_norm, w_ukv, m_i_bias, m_f_bias, w_proj_a, w_proj_m, w_out, ln1_g, ln1_b,
              w_grp, b_grp, w_exp, b_exp, w_gate, w_up, w_down, w_ple, w_ple_gate, ln2_g, ln2_b):
    B, S, _ = x.shape
    h = x
    for l in range(DEPTH):
        (a_q, a_ckv, i_q, i_k, i_w, m_q, m_k, m_v, m_o, m_i, m_f, g_a, g_m) = _split_cols(h @ w_in[l])
        kv = rms_norm(a_ckv, kv_norm[l]) @ w_ukv[l]
        y_a = dsa_attention(a_q.reshape(B, S, A_HEADS, A_HEAD_DIM), kv,
                            i_q.reshape(B, S, IDX_HEADS, IDX_DIM), i_k, i_w)
        y_m = mlstm(m_q.reshape(B, S, M_HEADS, M_QK_DIM), m_k.reshape(B, S, M_HEADS, M_QK_DIM),
                    m_v.reshape(B, S, M_HEADS, M_V_DIM), m_i + m_i_bias[l], m_f + m_f_bias[l])
        y_m = (y_m * jax.nn.sigmoid(m_o.astype(F32))).astype(h.dtype)
        mix = jax.nn.sigmoid(g_a) * (y_a @ w_proj_a[l]) + jax.nn.sigmoid(g_m) * (y_m @ w_proj_m[l])
        h = layer_norm(DN_ALPHA * h + mix @ w_out[l], ln1_g[l], ln1_b[l])
        ff = hier_moe(h, w_grp[l], b_grp[l], w_exp[l], b_exp[l], w_gate[l], w_up[l], w_down[l])
        ple = (p[l] @ w_ple[l]) * jax.nn.sigmoid(h @ w_ple_gate[l])
        h = layer_norm(DN_ALPHA * h + ff + ple, ln2_g[l], ln2_b[l])
    return h
```

```cpp
#include <hip/hip_runtime.h>
#include <cstdio>
#include <cstdint>

#ifndef MK_N_LAUNCHES
#define MK_N_LAUNCHES 1
#endif

#define LAS __attribute__((address_space(3)))
typedef unsigned short bf16_t;
typedef short bf16x8 __attribute__((ext_vector_type(8)));
typedef short s16x4 __attribute__((ext_vector_type(4)));
typedef float f32x4 __attribute__((ext_vector_type(4)));
typedef float f32x2 __attribute__((ext_vector_type(2)));
typedef unsigned u32x4 __attribute__((ext_vector_type(4)));
typedef unsigned u32x2 __attribute__((ext_vector_type(2)));

constexpr int T = 16384, D = 2048, SEQ = 2048, NBATCH = 8;
constexpr int LDP = 13824;
constexpr int C_AQ = 0, C_MV = 2048, C_MO = 4096, C_GA = 6144, C_GM = 8192, C_MQ = 10240, C_MK = 11264, C_IQ = 12288, C_CKV = 13312,
              C_IK = 13568, C_IW = 13632, C_MI = 13648, C_MF = 13656, C_END = 13664;
constexpr int INW = 13664;
constexpr float LN_EPS = 1e-5f;
constexpr float DN_ALPHA = 1.41421356237f;
constexpr int NEXP = 16, ECAP = 16384, SLOT_ROWS = 36864;

constexpr size_t MiB = 1u << 20;
constexpr size_t WS_CTL = 0;
constexpr size_t WS_WIN = 1 * MiB, WS_WPA = 55 * MiB, WS_WPM = 63 * MiB, WS_WOUT = 71 * MiB, WS_WPG = 79 * MiB, WS_WGU = 87 * MiB, WS_WD = 151 * MiB,
                 WS_WPLE = 183 * MiB, WS_WUKV = 184 * MiB, WS_WRH = 184 * MiB + 128 * 1024, WS_WRL = 184 * MiB + 256 * 1024;
constexpr size_t WS_PB = 185 * MiB, WS_KV = 193 * MiB, WS_LIST = 201 * MiB, WS_WL = 202 * MiB, WS_TOK = 203 * MiB, WS_HB = 204 * MiB, WS_MIX = 268 * MiB, WS_PROJ = 332 * MiB;
constexpr size_t WS_PRE = WS_MIX  , WS_PLE = WS_PROJ + 128 * MiB, WS_HMID = WS_PROJ + 192 * MiB, WS_Y = WS_PROJ + 228 * MiB;
constexpr size_t WS_WIN8 = 764 * MiB, WS_HB8 = 791 * MiB;
constexpr size_t WS_WPG8 = 823 * MiB, WS_WGU8 = 827 * MiB;
constexpr size_t WS_WD8 = 859 * MiB;
constexpr size_t WS_WPA8 = 875 * MiB;
constexpr size_t WS_WPM8 = 879 * MiB, WS_WOUT8 = 883 * MiB;
constexpr size_t WS_END = 887 * MiB;
constexpr size_t WS_YM8 = WS_WIN;
static_assert(WS_Y + (size_t)SLOT_ROWS * 2048 * 2 <= WS_END, "ws map");
constexpr int CW_BAR = 4096, CW_CNT = 8192;
constexpr size_t CTL_BYTES = 65536;

constexpr int LDS_BYTES = 147456;
constexpr int LDS_P = 1024;

__device__ __forceinline__ float bf2f(unsigned b) { return __uint_as_float(b << 16); }
__device__ __forceinline__ unsigned f2bf(float f) { unsigned u = __float_as_uint(f); return (u + 0x7fffu + ((u >> 16) & 1u)) >> 16; }
typedef __bf16 bf16x2_t __attribute__((ext_vector_type(2)));
__device__ __forceinline__ unsigned pk2(float lo, float hi) { const f32x2 v = {lo, hi}; return __builtin_bit_cast(unsigned, __builtin_convertvector(v, bf16x2_t)); }
__device__ __forceinline__ unsigned pk4_fp8(float a, float b, float c, float d) { int w = 0; w = __builtin_amdgcn_cvt_pk_fp8_f32(a, b, w, false); w = __builtin_amdgcn_cvt_pk_fp8_f32(c, d, w, true); return (unsigned)w; }
__device__ __forceinline__ float qdq8(float x) { const int w = __builtin_amdgcn_cvt_pk_fp8_f32(x, x, 0, false); return __builtin_amdgcn_cvt_f32_fp8(w, 0); }
__device__ __forceinline__ void un8(const u32x2 w, float (&o)[8]) { const f32x2 a = __builtin_amdgcn_cvt_pk_f32_fp8((int)w.x, false), b = __builtin_amdgcn_cvt_pk_f32_fp8((int)w.x, true), c = __builtin_amdgcn_cvt_pk_f32_fp8((int)w.y, false), d = __builtin_amdgcn_cvt_pk_f32_fp8((int)w.y, true);
    o[0] = a[0]; o[1] = a[1]; o[2] = b[0]; o[3] = b[1]; o[4] = c[0]; o[5] = c[1]; o[6] = d[0]; o[7] = d[1]; }
#define bf2_fp8(w_, hi_) __builtin_bit_cast(unsigned, __builtin_amdgcn_cvt_scalef32_pk_bf16_fp8((w_), 1.0f, (hi_)))
__device__ __forceinline__ float lo16(unsigned w) { return __uint_as_float(w << 16); }
__device__ __forceinline__ float hi16(unsigned w) { return __uint_as_float(w & 0xffff0000u); }
__device__ __forceinline__ float sigmoidf_(float x) { return __builtin_amdgcn_rcpf(1.0f + __expf(-x)); }
__device__ __forceinline__ float shx(float v, int m, int lane) { return __int_as_float(__builtin_amdgcn_ds_bpermute((lane ^ m) << 2, __float_as_int(v))); }
__device__ __forceinline__ float shl_(float v, int src) { return __int_as_float(__builtin_amdgcn_ds_bpermute(src << 2, __float_as_int(v))); }
__device__ __forceinline__ float wave_sum(float v, int lane) {
#pragma unroll
    for (int o = 1; o < 64; o <<= 1) v += shx(v, o, lane);
    return v;
}
__device__ __forceinline__ int lane_id_() { int l; asm volatile("v_mbcnt_lo_u32_b32 %0, -1, 0\n\tv_mbcnt_hi_u32_b32 %0, -1, %0" : "=v"(l)); return l; }
#define LDS_WAIT() asm volatile("s_waitcnt lgkmcnt(0)" ::: "memory")

#define XB_TMO      128
#define XB_XCNT(j)  (256  + 64 * (j))
#define XB_XSUB(j)  (1280 + 64 * (j))
#define XB_XGEN(j)  (2304 + 64 * (j))
#define XB_TOP      3328
#define XB_TOPGEN   3392
#define XCD_BAR_WORDS 3456
#define XB_SPIN_CAP (1u << 18)
__device__ __forceinline__ unsigned xb_ld(unsigned* p)              { return __hip_atomic_load(p, __ATOMIC_RELAXED, __HIP_MEMORY_SCOPE_AGENT); }
__device__ __forceinline__ unsigned xb_add(unsigned* p, unsigned v) { return __hip_atomic_fetch_add(p, v, __ATOMIC_RELAXED, __HIP_MEMORY_SCOPE_AGENT); }
__device__ __forceinline__ unsigned xb_xcc_id() { return (unsigned)__builtin_amdgcn_s_getreg((3 << 11) | 20) & 0xFu; }
#define XB_SPIN(cond, bar) do { unsigned _sp = 0; while (cond) { __builtin_amdgcn_s_sleep(1); \
    if ((++_sp & 255u) == 0u) { if (xb_ld(&(bar)[XB_TMO])) break; if (_sp > XB_SPIN_CAP) { atomicAdd(&(bar)[XB_TMO], 1u); break; } } } } while (0)
struct XcdBarrier { unsigned* bar; unsigned x; volatile LAS unsigned* st; };
__device__ __forceinline__ XcdBarrier xcd_barrier_post(unsigned* bar, volatile LAS unsigned* st, int tid) {
    XcdBarrier b; b.bar = bar; b.x = xb_xcc_id(); b.st = st;
    if (tid == 0) (void)xb_add(&bar[XB_XCNT(b.x)], 1u);
    return b;
}
__device__ __forceinline__ void xcd_barrier_complete(unsigned* bar, unsigned x, unsigned& nloc, unsigned& nx) {
    const unsigned G = gridDim.x * gridDim.y * gridDim.z;
    unsigned sum, cnt, mine, sp = 0u;
    for (;;) {
        sum = 0u; cnt = 0u; mine = 0u;
#pragma unroll
        for (unsigned j = 0; j < 16; ++j) { const unsigned c = xb_ld(&bar[XB_XCNT(j)]); sum += c; cnt += (c > 0u) ? 1u : 0u; mine = (j == x) ? c : mine; }
        if (sum == G) break;
        __builtin_amdgcn_s_sleep(1);
        if ((++sp & 255u) == 0u) { if (xb_ld(&bar[XB_TMO])) break; if (sp > XB_SPIN_CAP) { atomicAdd(&bar[XB_TMO], 1u); break; } }
    }
    nloc = mine > 0u ? mine : 1u; nx = cnt > 0u ? cnt : 1u;
}
__device__ __forceinline__ void xcd_barrier(const XcdBarrier& b, int tid) {
    asm volatile("s_waitcnt vmcnt(0)" ::: "memory");
    __syncthreads();
    if (tid == 0) {
        unsigned* bar = b.bar;
        __builtin_amdgcn_s_waitcnt(0);
        unsigned nloc = b.st[0], nx = b.st[1];
        if (nloc == 0u) { xcd_barrier_complete(bar, b.x, nloc, nx); b.st[0] = nloc; b.st[1] = nx; }
        const unsigned old = xb_add(&bar[XB_XSUB(b.x)], 1u);
        const unsigned gen = old / nloc;
        if (old + 1u == (gen + 1u) * nloc) {
            __builtin_amdgcn_fence(__ATOMIC_RELEASE, "agent");
            asm volatile("s_waitcnt vmcnt(0)" ::: "memory");
            const unsigned og = xb_add(&bar[XB_TOP], 1u);
            const unsigned tg = og / nx;
            if (og + 1u == (tg + 1u) * nx) xb_add(&bar[XB_TOPGEN], 1u);
            else XB_SPIN(xb_ld(&bar[XB_TOPGEN]) == tg, bar);
            __builtin_amdgcn_fence(__ATOMIC_ACQUIRE, "agent");
            xb_add(&bar[XB_XGEN(b.x)], 1u);
            asm volatile("s_waitcnt vmcnt(0)" ::: "memory");
        } else {
            XB_SPIN(xb_ld(&bar[XB_XGEN(b.x)]) == gen, bar);
            __builtin_amdgcn_fence(__ATOMIC_ACQUIRE, "agent");
            asm volatile("s_waitcnt vmcnt(0)" ::: "memory");
        }
    }
    __syncthreads();
}

namespace pg8 {
constexpr int BM = 256, BK = 64, HALF = 128, HTB = HALF * BK * 2, STAGE_BYTES = 8 * HTB, NXCD = 8, WGM = 8;
__device__ __forceinline__ int lds_byte(int r, int c) { const int st = (r >> 4) * 2 + (c >> 5), rr = r & 15, cc = c & 31, ob = rr * 64 + cc * 2; return st * 1024 + (ob ^ (((ob >> 9) & 1) << 5)); }
__device__ __forceinline__ void stage_rc(int b, int& R, int& C) { const int st = b / 1024, sb = b % 1024, swz = sb ^ (((sb >> 9) & 1) << 5); R = (st >> 1) * 16 + swz / 64; C = (st & 1) * 32 + (swz % 64) / 2; }
__device__ __forceinline__ int perm32(int rho) { const int n = rho >> 4, i = rho & 15; return 8 * (i >> 2) + 4 * n + (i & 3); }

struct Unit { const char* A; const char* B; const int* idx; int nvalid, row0, col0, aux; };

constexpr int NFP8 = 10240;
__device__ __forceinline__ constexpr bool inproj_tile_fp8(int pn) { return pn < NFP8 / 256; }
template <int M_, int N_, int LDA_, int LDB_, int MAP = 0, int BAL = 0> struct DenseSched {
    static constexpr int nM = M_ / BM, nN = MAP == 1 ? 24 : MAP == 2 ? 30 : N_ / BM, nwg = nM * nN;
    int G, c; const char* A; const char* B;
    __device__ __forceinline__ void init(int G_, int c_, const void* A_, const void* B_) { G = G_; c = c_; A = (const char*)A_; B = (const char*)B_; }
    __device__ __forceinline__ bool next(int i, Unit& u) const {
        int L = i * G + c;
        if (BAL == 1 && G == 256 && i >= 9) { if (c < 128 || i > 10) return false; L = 9 * 256 + (i - 9) * 128 + (c - 128); }
        if (L >= nwg) return false;
        int wgid = L; { constexpr int q = nwg / NXCD, r = nwg % NXCD; const int xcd = wgid % NXCD, off = wgid / NXCD; wgid = (xcd < r ? xcd * (q + 1) : r * (q + 1) + (xcd - r) * q) + off; }
        constexpr int nig = WGM * nN; const int gid = wgid / nig, fm = gid * WGM, gsz = (nM - fm) < WGM ? (nM - fm) : WGM;
        const int pm = fm + ((wgid % nig) % gsz); int pn = (wgid % nig) / gsz;
        if (MAP == 1) pn = pn < 8 ? pn : pn + 16;
        if (MAP == 2) pn = pn < 16 ? pn + 8 : pn + 24;
        u.A = A + (size_t)pm * ((size_t)BM * LDA_ * 2); u.B = B + (size_t)pn * ((size_t)BM * LDB_ * 2); u.idx = nullptr; u.nvalid = 256; u.row0 = pm * BM; u.col0 = pn * BM; u.aux = 0; return true;
    }
};
struct MoeSched {
    const LAS int* tpre; const LAS int* cnt; int NT, G, c, mode, bshift = 0;
    const char* Abase; const char* Bbase; const int* list;
    __device__ __forceinline__ bool next(int i, Unit& u) const {
        const int L = i * G + c; const int ntiles = __builtin_amdgcn_readfirstlane(tpre[16]);
        if (L >= ntiles * NT) return false;
        const int rt = L / NT, pn = L % NT; int e = 0;
#pragma unroll
        for (int k = 1; k < 16; ++k) e += (rt >= __builtin_amdgcn_readfirstlane(tpre[k])) ? 1 : 0;
        const int mt = rt - __builtin_amdgcn_readfirstlane(tpre[e]); const int ce = __builtin_amdgcn_readfirstlane(cnt[e]);
        int nv = ce - mt * 256; nv = nv > 256 ? 256 : nv;
        u.nvalid = nv; u.row0 = rt * 256; u.aux = e * ECAP + mt * 256;
        if (mode == 0) { u.A = Abase; u.idx = list + e * ECAP + mt * 256; u.B = Bbase + ((((size_t)e * 1024 + (size_t)pn * 256) * 2048 * 2) >> bshift); u.col0 = pn * 128; }
        else { u.A = Abase + (((size_t)rt * 256 * 512 * 2) >> bshift); u.idx = nullptr; u.B = Bbase + ((((size_t)e * 2048 + (size_t)pn * 256) * 512 * 2) >> bshift); u.col0 = pn * 256; }
        return true;
    }
};

#define EPI_REMAP() const int lane_ = fr + 16 * fq, fr2 = lane_ >> 2, fq2 = lane_ & 3, psrc = (fr2 + 16 * fq2) << 2
__device__ __forceinline__ u32x4 lperm4(const u32x4 w, const int psrc) { u32x4 r; r.x = (unsigned)__builtin_amdgcn_ds_bpermute(psrc, (int)w.x); r.y = (unsigned)__builtin_amdgcn_ds_bpermute(psrc, (int)w.y);
    r.z = (unsigned)__builtin_amdgcn_ds_bpermute(psrc, (int)w.z); r.w = (unsigned)__builtin_amdgcn_ds_bpermute(psrc, (int)w.w); return r; }
__device__ __forceinline__ f32x4 lperm4f(const f32x4 v, const int psrc) { return __builtin_bit_cast(f32x4, lperm4(__builtin_bit_cast(u32x4, v), psrc)); }
template <bool NT = false> struct EpiStoreBf16T {
    static constexpr bool PERM = true;
    bf16_t* O; int ldc;
    __device__ __forceinline__ void operator()(const f32x4 (&acc)[2][2][4][2], const Unit& u, int wr, int wc, int fr, int fq) const {
        EPI_REMAP();
        const int row0 = u.row0 + wr * 64 + fr2, col0 = u.col0 + wc * 32 + 8 * fq2;
#pragma unroll
        for (int ai = 0; ai < 2; ++ai)
#pragma unroll
            for (int m = 0; m < 4; ++m) { bf16_t* rowp = O + (size_t)(row0 + ai * HALF + m * 16) * ldc + col0;
#pragma unroll
                for (int bj = 0; bj < 2; ++bj) { const f32x4 v0 = acc[ai][bj][m][0], v1 = acc[ai][bj][m][1];
                    u32x4 w; w.x = pk2(v0[0], v0[1]); w.y = pk2(v0[2], v0[3]); w.z = pk2(v1[0], v1[1]); w.w = pk2(v1[2], v1[3]);
                    w = lperm4(w, psrc);
                    if (NT) __builtin_nontemporal_store(w, (u32x4*)(rowp + bj * HALF)); else *(u32x4*)(rowp + bj * HALF) = w; } }
    }
};
typedef EpiStoreBf16T<false> EpiStoreBf16;
typedef EpiStoreBf16T<true> EpiStoreBf16NT;
template <bool ADD> struct EpiGate {
    static constexpr bool PERM = true;
    bf16_t* O; int ldo; const bf16_t* gate; int ldg; unsigned char* O8; int ld8;
    __device__ __forceinline__ void operator()(const f32x4 (&acc)[2][2][4][2], const Unit& u, int wr, int wc, int fr, int fq) const {
        EPI_REMAP();
        const int row0 = u.row0 + wr * 64 + fr2, col0 = u.col0 + wc * 32 + 8 * fq2;
#pragma unroll
        for (int ai = 0; ai < 2; ++ai)
#pragma unroll
            for (int m = 0; m < 4; ++m) { const size_t r = (size_t)(row0 + ai * HALF + m * 16);
#pragma unroll
                for (int bj = 0; bj < 2; ++bj) { const f32x4 v0 = lperm4f(acc[ai][bj][m][0], psrc), v1 = lperm4f(acc[ai][bj][m][1], psrc);
                    const u32x4 gw = __builtin_nontemporal_load((const u32x4*)(gate + r * ldg + col0 + bj * HALF));
                    float o[8] = {0.f, 0.f, 0.f, 0.f, 0.f, 0.f, 0.f, 0.f};
                    if (ADD) { const u32x4 ow = *(const u32x4*)(O + r * ldo + col0 + bj * HALF);
                        o[0] = lo16(ow.x); o[1] = hi16(ow.x); o[2] = lo16(ow.y); o[3] = hi16(ow.y); o[4] = lo16(ow.z); o[5] = hi16(ow.z); o[6] = lo16(ow.w); o[7] = hi16(ow.w); }
                    o[0] += v0[0] * sigmoidf_(lo16(gw.x)); o[1] += v0[1] * sigmoidf_(hi16(gw.x)); o[2] += v0[2] * sigmoidf_(lo16(gw.y)); o[3] += v0[3] * sigmoidf_(hi16(gw.y));
                    o[4] += v1[0] * sigmoidf_(lo16(gw.z)); o[5] += v1[1] * sigmoidf_(hi16(gw.z)); o[6] += v1[2] * sigmoidf_(lo16(gw.w)); o[7] += v1[3] * sigmoidf_(hi16(gw.w));
                    if (O8) {
#pragma unroll
                        for (int e = 0; e < 8; ++e) o[e] = fminf(fmaxf(o[e], -440.f), 440.f);
                        u32x2 w8; w8.x = pk4_fp8(o[0], o[1], o[2], o[3]); w8.y = pk4_fp8(o[4], o[5], o[6], o[7]);
                        *(u32x2*)(O8 + r * ld8 + col0 + bj * HALF) = w8; }
                    else { u32x4 w; w.x = pk2(o[0], o[1]); w.y = pk2(o[2], o[3]); w.z = pk2(o[4], o[5]); w.w = pk2(o[6], o[7]);
                        *(u32x4*)(O + r * ldo + col0 + bj * HALF) = w; } }
                asm volatile("" ::: "memory"); }
    }
};
struct EpiPleGate {
    static constexpr bool PERM = true;
    bf16_t* P; int ld; const bf16_t* H; float alpha;
    __device__ __forceinline__ void operator()(const f32x4 (&acc)[2][2][4][2], const Unit& u, int wr, int wc, int fr, int fq) const {
        EPI_REMAP();
        const int row0 = u.row0 + wr * 64 + fr2, col0 = u.col0 + wc * 32 + 8 * fq2;
#pragma unroll
        for (int ai = 0; ai < 2; ++ai)
#pragma unroll
            for (int m = 0; m < 4; ++m) { bf16_t* rowp = P + (size_t)(row0 + ai * HALF + m * 16) * ld + col0;
#pragma unroll
                for (int bj = 0; bj < 2; ++bj) { const f32x4 v0 = lperm4f(acc[ai][bj][m][0], psrc), v1 = lperm4f(acc[ai][bj][m][1], psrc);
                    const u32x4 pw = *(const u32x4*)(rowp + bj * HALF);
                    const u32x4 hw = __builtin_nontemporal_load((const u32x4*)(H + (rowp - P) + bj * HALF));
                    u32x4 w; w.x = pk2(alpha * lo16(hw.x) + lo16(pw.x) * sigmoidf_(v0[0]), alpha * hi16(hw.x) + hi16(pw.x) * sigmoidf_(v0[1])); w.y = pk2(alpha * lo16(hw.y) + lo16(pw.y) * sigmoidf_(v0[2]), alpha * hi16(hw.y) + hi16(pw.y) * sigmoidf_(v0[3]));
                    w.z = pk2(alpha * lo16(hw.z) + lo16(pw.z) * sigmoidf_(v1[0]), alpha * hi16(hw.z) + hi16(pw.z) * sigmoidf_(v1[1])); w.w = pk2(alpha * lo16(hw.w) + lo16(pw.w) * sigmoidf_(v1[2]), alpha * hi16(hw.w) + hi16(pw.w) * sigmoidf_(v1[3]));
                    *(u32x4*)(rowp + bj * HALF) = w; }
                asm volatile("" ::: "memory"); }
    }
};
struct EpiSwiglu {
    static constexpr bool PERM = true;
    unsigned char* H; const float* wl;
    __device__ __forceinline__ void operator()(const f32x4 (&acc)[2][2][4][2], const Unit& u, int wr, int wc, int fr, int fq) const {
        EPI_REMAP();
        const int rl0 = wr * 64 + fr;
#pragma unroll
        for (int ai = 0; ai < 2; ++ai)
#pragma unroll
            for (int m = 0; m < 4; ++m) { const int rl = rl0 + ai * HALF + m * 16; const float cw = rl < u.nvalid ? 16.f * wl[u.aux + rl] : 0.f;
                const f32x4 g0 = acc[ai][0][m][0], g1 = acc[ai][0][m][1], u0 = acc[ai][1][m][0], u1 = acc[ai][1][m][1];
                float o[8];
#pragma unroll
                for (int j = 0; j < 4; ++j) { o[j] = fminf(fmaxf(g0[j] * sigmoidf_(g0[j]) * u0[j] * cw, -440.f), 440.f); o[4 + j] = fminf(fmaxf(g1[j] * sigmoidf_(g1[j]) * u1[j] * cw, -440.f), 440.f); }
                u32x2 w; w.x = (unsigned)__builtin_amdgcn_ds_bpermute(psrc, (int)pk4_fp8(o[0], o[1], o[2], o[3])); w.y = (unsigned)__builtin_amdgcn_ds_bpermute(psrc, (int)pk4_fp8(o[4], o[5], o[6], o[7]));
                *(u32x2*)(H + (size_t)(u.row0 + wr * 64 + fr2 + ai * HALF + m * 16) * 512 + u.col0 + wc * 32 + 8 * fq2) = w;
                asm volatile("" ::: "memory"); }
    }
};
struct EpiResBf16 {
    static constexpr bool PERM = true;
    bf16_t* O; const bf16_t* base; float alpha; int ldc;
    __device__ __forceinline__ void operator()(const f32x4 (&acc)[2][2][4][2], const Unit& u, int wr, int wc, int fr, int fq) const {
        EPI_REMAP();
        const int row0 = u.row0 + wr * 64 + fr2, col0 = u.col0 + wc * 32 + 8 * fq2;
#pragma unroll
        for (int ai = 0; ai < 2; ++ai)
#pragma unroll
            for (int m = 0; m < 4; ++m) { const size_t off = (size_t)(row0 + ai * HALF + m * 16) * ldc + col0;
#pragma unroll
                for (int bj = 0; bj < 2; ++bj) { const f32x4 v0 = lperm4f(acc[ai][bj][m][0], psrc), v1 = lperm4f(acc[ai][bj][m][1], psrc);
                    const u32x4 bw = *(const u32x4*)(base + off + bj * HALF);
                    u32x4 w; w.x = pk2(alpha * lo16(bw.x) + v0[0], alpha * hi16(bw.x) + v0[1]); w.y = pk2(alpha * lo16(bw.y) + v0[2], alpha * hi16(bw.y) + v0[3]);
                    w.z = pk2(alpha * lo16(bw.z) + v1[0], alpha * hi16(bw.z) + v1[1]); w.w = pk2(alpha * lo16(bw.w) + v1[2], alpha * hi16(bw.w) + v1[3]);
                    *(u32x4*)(O + off + bj * HALF) = w; }
                asm volatile("" ::: "memory"); }
    }
};

template <class Epi, class Sched, bool GATHER, bool ALIGN_EPI, int K, int lda, int ldb, bool FP8 = false, int SCL_A = 0x7f7f7f7f, int SCL_B = 0x79797979>
__device__ __forceinline__ void gemm_phase(LAS unsigned char* lds, const int tid_in, LAS unsigned* toktab, const Sched& S, const Epi& E) {
    int tid_ = tid_in; asm volatile("" : "+v"(tid_));
    const int tid = tid_, wid = __builtin_amdgcn_readfirstlane(tid >> 6), lane = tid & 63, wr = wid >> 2, wc = wid & 3, fr = lane & 15, fq = lane >> 4;
    constexpr int nt = K / BK;
    unsigned voffA[2], voffB[2]; int rA[2]; unsigned cA2[2];
#pragma unroll
    for (int i = 0; i < 2; ++i) { int R, C; stage_rc(tid * 16 + i * 8192, R, C); const int Rb = Epi::PERM ? ((R & ~31) + perm32(R & 31)) : R;
        voffA[i] = (unsigned)(R * lda + C) * 2u; voffB[i] = (unsigned)(Rb * ldb + C) * 2u; rA[i] = R; cA2[i] = (unsigned)C * 2u; }
    constexpr size_t kstep = (size_t)(BK * 2);
    constexpr size_t hstepA = (size_t)HALF * lda * 2, hstepB = (size_t)HALF * ldb * 2;
    const unsigned ldsw = (unsigned)wid * 1024u;
    const int aoff = lds_byte(wr * 64 + fr, fq * 8), boff = lds_byte(wc * 32 + fr, fq * 8);
#define PG8_SA(b, h) (((b) * 2 + (h)) * HTB)
#define PG8_SB(b, h) ((4 + (b) * 2 + (h)) * HTB)
#define PG8_STAGE_B(bufoff, gbase) do { _Pragma("unroll") for (int _i = 0; _i < 2; ++_i) \
        __builtin_amdgcn_global_load_lds((const unsigned*)((const char*)(gbase) + voffB[_i]), (LAS unsigned*)(lds + (bufoff) + ldsw + _i * 8192), 16, 0, 0); } while (0)
#define PG8_STAGE_A(bufoff, gbase, h, nx) do { _Pragma("unroll") for (int _i = 0; _i < 2; ++_i) { \
        const char* _g = GATHER ? (const char*)(gbase) : (const char*)(gbase) + (h) * hstepA; \
        const unsigned _o = GATHER ? (toktab[(((nx) ? (tpar ^ 1) : tpar) << 8) + (h) * HALF + rA[_i]] + cA2[_i]) : voffA[_i]; \
        __builtin_amdgcn_global_load_lds((const unsigned*)(_g + _o), (LAS unsigned*)(lds + (bufoff) + ldsw + _i * 8192), 16, 0, 0); } } while (0)
#define PG8_LDA(dst, b, h) do { _Pragma("unroll") for (int m = 0; m < 4; ++m) _Pragma("unroll") for (int k = 0; k < 2; ++k) dst[m][k] = *(const LAS bf16x8*)(lds + PG8_SA(b, h) + aoff + m * 2048 + k * 1024); } while (0)
#define PG8_LDB(dst, b, h) do { _Pragma("unroll") for (int n = 0; n < 2; ++n) _Pragma("unroll") for (int k = 0; k < 2; ++k) dst[n][k] = *(const LAS bf16x8*)(lds + PG8_SB(b, h) + boff + n * 2048 + k * 1024); } while (0)
#define PG8_MMA(ai, bj, At, Bt) do { __builtin_amdgcn_s_setprio(1); _Pragma("unroll") for (int m = 0; m < 4; ++m) _Pragma("unroll") for (int n = 0; n < 2; ++n) { \
        if constexpr (FP8) { typedef int v4i_ __attribute__((ext_vector_type(4))); typedef int v8i_ __attribute__((ext_vector_type(8))); \
            const v8i_ b8 = __builtin_shufflevector(__builtin_bit_cast(v4i_, Bt[n][0]), __builtin_bit_cast(v4i_, Bt[n][1]), 0, 1, 2, 3, 4, 5, 6, 7); \
            const v8i_ a8 = __builtin_shufflevector(__builtin_bit_cast(v4i_, At[m][0]), __builtin_bit_cast(v4i_, At[m][1]), 0, 1, 2, 3, 4, 5, 6, 7); \
            asm volatile("v_mfma_scale_f32_16x16x128_f8f6f4 %0, %1, %2, %0, %3, %4 op_sel_hi:[0,0,0]" : "+v"(acc[ai][bj][m][n]) : "v"(b8), "v"(a8), "v"(sclB), "v"(sclA)); }     \
        else { _Pragma("unroll") for (int k = 0; k < 2; ++k) acc[ai][bj][m][n] = __builtin_amdgcn_mfma_f32_16x16x32_bf16(Bt[n][k], At[m][k], acc[ai][bj][m][n], 0, 0, 0); } } \
        __builtin_amdgcn_s_setprio(0); } while (0)
#define PG8_WAIT_V(n) asm volatile("s_waitcnt vmcnt(" #n ")" ::: "memory")
#define PG8_WAIT_L(n) asm volatile("s_waitcnt lgkmcnt(" #n ")" ::: "memory")
#define PG8_BAR __builtin_amdgcn_s_barrier()
#define PG8_SCHED __builtin_amdgcn_sched_barrier(0)
#define PG8_LOAD_OFFS(uu, par) do { if (tid < 256) { const int _tok = tid < (uu).nvalid ? (uu).idx[tid] : 0; toktab[((par) << 8) + tid] = (unsigned)(_tok * lda) * 2u; } } while (0)
    int tpar = 0;
    const int sclB = SCL_B, sclA = SCL_A; (void)sclA; (void)sclB;
    Unit cur, nxt; int ui = 0;
    if (!S.next(0, cur)) return;
    f32x4 acc[2][2][4][2];
#pragma unroll
    for (int a = 0; a < 2; ++a)
#pragma unroll
        for (int b = 0; b < 2; ++b)
#pragma unroll
            for (int m = 0; m < 4; ++m)
#pragma unroll
                for (int n = 0; n < 2; ++n) acc[a][b][m][n] = (f32x4){0.f, 0.f, 0.f, 0.f};
    bf16x8 At[4][2], B0[2][2], B1[2][2];
    const char* cA = cur.A; const char* cB = cur.B;
    if constexpr (GATHER) { PG8_LOAD_OFFS(cur, 0); asm volatile("s_waitcnt lgkmcnt(0)" ::: "memory"); __builtin_amdgcn_s_barrier(); }
    PG8_STAGE_B(PG8_SB(0, 0), cB); PG8_STAGE_B(PG8_SB(0, 1), cB + hstepB); PG8_STAGE_A(PG8_SA(0, 0), cA, 0, false); PG8_STAGE_A(PG8_SA(0, 1), cA, 1, false);
    if (wr == 1) PG8_BAR;
    PG8_WAIT_V(2); PG8_BAR;
    PG8_STAGE_B(PG8_SB(1, 0), cB + kstep); PG8_STAGE_A(PG8_SA(1, 0), cA + kstep, 0, false); PG8_STAGE_B(PG8_SB(1, 1), cB + hstepB + kstep);
    PG8_WAIT_V(6); PG8_BAR;
    for (;;) {
        const bool has_next = S.next(ui + 1, nxt);
        const char* nA = has_next ? nxt.A : cA; const char* nB = has_next ? nxt.B : cB;
        if constexpr (GATHER) { if (has_next) { PG8_LOAD_OFFS(nxt, tpar ^ 1); } else if (tid < 256) toktab[((tpar ^ 1) << 8) + tid] = toktab[(tpar << 8) + tid]; }
#pragma unroll 1
        for (int t = 0; t < nt; t += 2) {
            const bool last = (t == nt - 2);
            const char* a1 = cA + (size_t)(t + 1) * kstep;
            const char* a2 = last ? nA : cA + (size_t)(t + 2) * kstep; const char* b2 = last ? nB : cB + (size_t)(t + 2) * kstep;
            const char* a3 = a2 + kstep; const char* b3 = b2 + kstep;
            PG8_LDB(B0, 0, 0); PG8_LDB(B1, 0, 1); PG8_SCHED; PG8_LDA(At, 0, 0); PG8_STAGE_A(PG8_SA(1, 1), a1, 1, false);
            PG8_WAIT_V(8); PG8_WAIT_L(0); PG8_BAR; PG8_MMA(0, 0, At, B0); PG8_MMA(0, 1, At, B1); PG8_BAR; PG8_SCHED;
            PG8_LDA(At, 0, 1); PG8_STAGE_B(PG8_SB(0, 0), b2); PG8_STAGE_B(PG8_SB(0, 1), b2 + hstepB); PG8_STAGE_A(PG8_SA(0, 0), a2, 0, last);
            PG8_WAIT_V(8); PG8_WAIT_L(0); PG8_BAR; PG8_MMA(1, 0, At, B0); PG8_MMA(1, 1, At, B1); PG8_BAR; PG8_SCHED;
            PG8_LDB(B0, 1, 0); PG8_LDB(B1, 1, 1); PG8_SCHED; PG8_LDA(At, 1, 0); PG8_STAGE_A(PG8_SA(0, 1), a2, 1, last);
            PG8_WAIT_V(8); PG8_WAIT_L(0); PG8_BAR; PG8_MMA(0, 0, At, B0); PG8_MMA(0, 1, At, B1); PG8_BAR; PG8_SCHED;
            PG8_LDA(At, 1, 1); PG8_STAGE_B(PG8_SB(1, 0), b3); PG8_STAGE_B(PG8_SB(1, 1), b3 + hstepB); PG8_STAGE_A(PG8_SA(1, 0), a3, 0, last);
            PG8_WAIT_V(8); PG8_WAIT_L(0); PG8_BAR; PG8_MMA(1, 0, At, B0); PG8_MMA(1, 1, At, B1); PG8_BAR; PG8_SCHED;
        }
        if constexpr (ALIGN_EPI) { if (wr == 0) PG8_BAR; }
        { int te_ = tid; asm volatile("" : "+v"(te_)); const int le_ = te_ & 63; E(acc, cur, wr, wc, le_ & 15, le_ >> 4); }
        if (!has_next) break;
#pragma unroll
        for (int a = 0; a < 2; ++a)
#pragma unroll
            for (int b = 0; b < 2; ++b)
#pragma unroll
                for (int m = 0; m < 4; ++m)
#pragma unroll
                    for (int n = 0; n < 2; ++n) acc[a][b][m][n] = (f32x4){0.f, 0.f, 0.f, 0.f};
        cur = nxt; cA = nA; cB = nB; ++ui;
        if constexpr (GATHER) tpar ^= 1;
        if constexpr (ALIGN_EPI) { if (wr == 1) PG8_BAR; }
    }
    PG8_WAIT_V(0);
    if constexpr (!ALIGN_EPI) { if (wr == 0) PG8_BAR; }
    PG8_BAR;
#undef PG8_SA
#undef PG8_SB
#undef PG8_STAGE_A
#undef PG8_STAGE_B
#undef PG8_LDA
#undef PG8_LDB
#undef PG8_MMA
#undef PG8_WAIT_V
#undef PG8_WAIT_L
#undef PG8_BAR
#undef PG8_SCHED
#undef PG8_LOAD_OFFS
}
}

struct Params { const float* in[23]; float* out; unsigned char* ws; int ph_lo, ph_hi, li, pad; };
#define CAS __attribute__((address_space(4)))
struct Ctx {
    LAS unsigned char* lds; LAS unsigned char* P;
    int tid, lane, wave, vcu, G;
    const CAS Params* kp;
};
#define PHASE_ENTER() const CAS Params* q_ = F0.kp; asm volatile("" : "+s"(q_)); int tid_ = F0.wave * 64 + lane_id_(); asm volatile("" : "+v"(tid_)); \
    Ctx F = F0; F.tid = tid_; F.lane = tid_ & 63; F.wave = __builtin_amdgcn_readfirstlane(tid_ >> 6); \
    unsigned char* const ws = q_->ws; unsigned* const ctl = (unsigned*)ws; (void)ctl
#define PIN(i) (q_->in[i])
enum { I_X = 0, I_P, I_WIN, I_KVN, I_WUKV, I_MIB, I_MFB, I_WPA, I_WPM, I_WOUT, I_LN1G, I_LN1B, I_WGRP, I_BGRP, I_WEXP, I_BEXP, I_WGATE, I_WUP, I_WDOWN, I_WPLE, I_WPG, I_LN2G, I_LN2B };

__device__ __forceinline__ int win_src_col(int n) {
    if (n < 2048) return n;
    if (n < 4096) return 5456 + (n - 2048);
    if (n < 6144) return 7504 + (n - 4096);
    if (n < 8192) return 9568 + (n - 6144);
    if (n < 10240) return 11616 + (n - 8192);
    if (n < 11264) return 3408 + (n - 10240);
    if (n < 12288) return 4432 + (n - 11264);
    if (n < 13312) return 2304 + (n - 12288);
    if (n < 13568) return 2048 + (n - 13312);
    if (n < 13632) return 3328 + (n - 13568);
    if (n < 13648) return 3392 + (n - 13632);
    if (n < 13656) return 9552 + (n - 13648);
    if (n < 13664) return 9560 + (n - 13656);
    return -1;
}
struct CvItem { const float* src; int ldsrc, srccol; bf16_t* dst; int dstld; unsigned char* dst8; };
__device__ __forceinline__ void cv_load(const CvItem& I, f32x4 (&v)[16], int lane) {
    const int r = lane >> 4;
#pragma unroll
    for (int i = 0; i < 16; ++i) v[i] = I.srccol >= 0 ? __builtin_nontemporal_load((const f32x4*)(I.src + (size_t)(4 * i + r) * I.ldsrc + I.srccol)) : (f32x4){0.f, 0.f, 0.f, 0.f};
}
__device__ __forceinline__ void cv_store(const CvItem& I, const f32x4 (&v)[16], LAS bf16_t* scr, int lane) {
    const int r = lane >> 4, c4 = lane & 15;
#pragma unroll
    for (int i = 0; i < 16; ++i) { const int k = 4 * i + r;
#pragma unroll
        for (int e = 0; e < 4; ++e) scr[(4 * c4 + e) * 66 + k] = (bf16_t)f2bf(v[i][e]); }
    LDS_WAIT(); asm volatile("" ::: "memory");
    const int ch = lane & 7;
#pragma unroll
    for (int j = 0; j < 8; ++j) { const int n = (lane >> 3) + 8 * j; const LAS unsigned* sp = (const LAS unsigned*)(scr + n * 66 + ch * 8);
        u32x4 o; o.x = sp[0]; o.y = sp[1]; o.z = sp[2]; o.w = sp[3];
        if (I.dst) *(u32x4*)(I.dst + (size_t)n * I.dstld + 8 * ch) = o;
        if (I.dst8) { u32x2 o8; o8.x = pk4_fp8(lo16(o.x) * 64.f, hi16(o.x) * 64.f, lo16(o.y) * 64.f, hi16(o.y) * 64.f); o8.y = pk4_fp8(lo16(o.z) * 64.f, hi16(o.z) * 64.f, lo16(o.w) * 64.f, hi16(o.w) * 64.f);
            *(u32x2*)(I.dst8 + (size_t)n * I.dstld + 8 * ch) = o8; } }
    LDS_WAIT(); asm volatile("" ::: "memory");
}
namespace cv { constexpr int N0 = 216 * 32, N1 = 32 * 32, N5 = 16 * 16 * 32, N6 = 16 * 32 * 8, N7 = 32 * 4, N8 = 4 * 4, NIT = N0 + 4 * N1 + N5 + N6 + N7 + N8; }
#define CV_DECODE(I, it_) do { int r = (it_); \
        if (r < cv::N0) { const int kb = r / 216, grp = r % 216; const int n = grp * 64 + 4 * c4; const bool f8 = pg8::inproj_tile_fp8(grp >> 2); \
            I.src = PIN(I_WIN) + (size_t)l * 2048 * INW + (size_t)kb * 64 * INW; I.ldsrc = INW; I.srccol = win_src_col(n); I.dstld = 2048; \
            I.dst = f8 ? (bf16_t*)nullptr : (bf16_t*)(ws + WS_WIN) + (size_t)grp * 64 * 2048 + kb * 64; I.dst8 = f8 ? ws + WS_WIN8 + (size_t)grp * 64 * 2048 + kb * 64 : (unsigned char*)nullptr; break; } \
        r -= cv::N0; \
        if (r < 4 * cv::N1) { const int which = r / cv::N1, rr = r % cv::N1, kb = rr / 32, grp = rr % 32; \
            const float* src_ = which == 0 ? PIN(I_WPA) : which == 1 ? PIN(I_WPM) : which == 2 ? PIN(I_WOUT) : PIN(I_WPG); \
            I.src = src_ + (size_t)l * 2048 * 2048 + (size_t)kb * 64 * 2048; I.ldsrc = 2048; I.srccol = grp * 64 + 4 * c4; I.dstld = 2048; \
            I.dst = which == 1 ? (bf16_t*)(ws + WS_WPM) + (size_t)grp * 64 * 2048 + kb * 64 : (bf16_t*)nullptr; \
            I.dst8 = ws + (which == 0 ? WS_WPA8 : which == 1 ? WS_WPM8 : which == 2 ? WS_WOUT8 : WS_WPG8) + (size_t)grp * 64 * 2048 + kb * 64; break; } \
        r -= 4 * cv::N1; \
        if (r < cv::N5) { const int e = r / 512, rr = r % 512, kb = rr / 16, grp = rr % 16; const int drow = grp * 64, tile = drow / 256, w = drow % 256; const bool isup = w >= 128; \
            I.src = (isup ? PIN(I_WUP) : PIN(I_WGATE)) + ((size_t)l * 16 + e) * 2048 * 512 + (size_t)kb * 64 * 512; I.ldsrc = 512; I.srccol = tile * 128 + (isup ? w - 128 : w) + 4 * c4; I.dstld = 2048; \
            I.dst = nullptr; I.dst8 = ws + WS_WGU8 + ((size_t)e * 1024 + drow) * 2048 + kb * 64; break; } \
        r -= cv::N5; \
        if (r < cv::N6) { const int e = r / 256, rr = r % 256, kb = rr / 32, grp = rr % 32; \
            I.src = PIN(I_WDOWN) + ((size_t)l * 16 + e) * 512 * 2048 + (size_t)kb * 64 * 2048; I.ldsrc = 2048; I.srccol = grp * 64 + 4 * c4; I.dstld = 512; \
            I.dst = nullptr; I.dst8 = ws + WS_WD8 + ((size_t)e * 2048 + grp * 64) * 512 + kb * 64; break; } \
        r -= cv::N6; \
        if (r < cv::N7) { const int kb = r / 32, grp = r % 32; \
            I.src = PIN(I_WPLE) + (size_t)l * 256 * 2048 + (size_t)kb * 64 * 2048; I.ldsrc = 2048; I.srccol = grp * 64 + 4 * c4; I.dstld = 256; \
            I.dst = (bf16_t*)(ws + WS_WPLE) + (size_t)grp * 64 * 256 + kb * 64; I.dst8 = nullptr; break; } \
        r -= cv::N7; \
        { const int kb = r / 4, grp = r % 4; \
            I.src = PIN(I_WUKV) + (size_t)l * 256 * 256 + (size_t)kb * 64 * 256; I.ldsrc = 256; I.srccol = grp * 64 + 4 * c4; I.dstld = 256; \
            I.dst = (bf16_t*)(ws + WS_WUKV) + (size_t)grp * 64 * 256 + kb * 64; I.dst8 = nullptr; } } while (0)
__device__ __forceinline__ void phase_convert(const Ctx& F0, int l, int late) {
    PHASE_ENTER();
    LAS bf16_t* scr = (LAS bf16_t*)(F.P + F.wave * 8448);
    const int gw = F.vcu * 8 + F.wave, NGW = F.G * 8, lane = F.lane, c4 = lane & 15;
    {
        constexpr int NA = cv::N0 + cv::N8, NB = cv::NIT - NA;
#define CV_MAP(j_) (late ? cv::N0 + (j_) : ((j_) < cv::N0 ? (j_) : (j_) - cv::N0 + (cv::NIT - cv::N8)))
        const int nit = late ? NB : NA;
        CvItem I0, I1; f32x4 va[16], vb[16];
        int it = gw;
        if (it < nit) { CV_DECODE(I0, CV_MAP(it)); cv_load(I0, va, lane); }
#pragma unroll 1
        for (; it < nit; it += NGW) {
            const int itn = it + NGW;
            if (itn < nit) { CV_DECODE(I1, CV_MAP(itn)); cv_load(I1, vb, lane); }
            cv_store(I0, va, scr, lane);
            I0 = I1;
#pragma unroll
            for (int i = 0; i < 16; ++i) va[i] = vb[i];
        }
#undef CV_MAP
    }
    if (late) return;
    const size_t gt = (size_t)F.vcu * 512 + F.tid, NT = (size_t)F.G * 512;
    for (size_t i = gt; i < 32 * 2048; i += NT) { const int c = (int)(i / 2048), k = (int)(i % 2048);
        float w = 0.f; if (c < 4) w = PIN(I_WGRP)[((size_t)l * 2048 + k) * 4 + c]; else if (c < 20) w = PIN(I_WEXP)[((size_t)l * 2048 + k) * 16 + (c - 4)];
        const unsigned h = f2bf(w); const float rem = w - bf2f(h);
        ((bf16_t*)(ws + WS_WRH))[i] = (bf16_t)h; ((bf16_t*)(ws + WS_WRL))[i] = (bf16_t)f2bf(rem); }
    { const f32x4* src = (const f32x4*)(PIN(I_P) + (size_t)l * T * 256); u32x4* dst = (u32x4*)(ws + WS_PB);
      for (size_t i = gt; i < (size_t)T * 256 / 8; i += NT) { const f32x4 a = __builtin_nontemporal_load(src + 2 * i), b = __builtin_nontemporal_load(src + 2 * i + 1); u32x4 o; o.x = pk2(a[0], a[1]); o.y = pk2(a[2], a[3]); o.z = pk2(b[0], b[1]); o.w = pk2(b[2], b[3]); dst[i] = o; } }
    if (l == 0) { const f32x4* src = (const f32x4*)PIN(I_X); u32x4* dst = (u32x4*)(ws + WS_HB); u32x2* dst8 = (u32x2*)(ws + WS_HB8);
      for (size_t i0 = gt; i0 < (size_t)T * D / 8; i0 += 4 * NT) { f32x4 a[4], b[4];
#pragma unroll
        for (int u = 0; u < 4; ++u) { const size_t i = i0 + u * NT; a[u] = __builtin_nontemporal_load(src + 2 * i); b[u] = __builtin_nontemporal_load(src + 2 * i + 1); }
#pragma unroll
        for (int u = 0; u < 4; ++u) { const size_t i = i0 + u * NT; u32x4 o; o.x = pk2(a[u][0], a[u][1]); o.y = pk2(a[u][2], a[u][3]); o.z = pk2(b[u][0], b[u][1]); o.w = pk2(b[u][2], b[u][3]); dst[i] = o;
            u32x2 o8; o8.x = pk4_fp8(a[u][0], a[u][1], a[u][2], a[u][3]); o8.y = pk4_fp8(b[u][0], b[u][1], b[u][2], b[u][3]); dst8[i] = o8;
            } } }
}

__device__ __forceinline__ void phase_kv(const Ctx& F0, int l) {
    PHASE_ENTER();
    const bf16_t* proj = (const bf16_t*)(ws + WS_PROJ); const bf16_t* W = (const bf16_t*)(ws + WS_WUKV); bf16_t* kv = (bf16_t*)(ws + WS_KV);
    const float* gn = q_->in[I_KVN] + l * 256;
    const int lane = F.lane, n16 = lane & 15, g = lane >> 4;
    const int gw = F.vcu * 8 + F.wave, NGW = F.G * 8;
    const int psrc = (4 * n16 + g) << 2, lr = lane >> 2, lp = lane & 3;
    for (int task = gw; task < T / 8; task += NGW) {
        const int t0 = (task >> 1) * 16, nt0 = (task & 1) * 8;
        const bf16_t* xr = proj + (size_t)(t0 + lr) * LDP + C_CKV + 8 * lp;
        u32x4 raw[8]; float ss = 0.f;
#pragma unroll
        for (int ks = 0; ks < 8; ++ks) { raw[ks] = pg8::lperm4(*(const u32x4*)(xr + ks * 32), psrc);
            const float a0 = lo16(raw[ks].x), a1 = hi16(raw[ks].x), a2 = lo16(raw[ks].y), a3 = hi16(raw[ks].y), a4 = lo16(raw[ks].z), a5 = hi16(raw[ks].z), a6 = lo16(raw[ks].w), a7 = hi16(raw[ks].w);
            ss += (a0 * a0 + a1 * a1) + (a2 * a2 + a3 * a3) + (a4 * a4 + a5 * a5) + (a6 * a6 + a7 * a7); }
        ss += shx(ss, 16, lane); ss += shx(ss, 32, lane);
        const float rstd = 1.0f / sqrtf(ss * (1.0f / 256.0f) + LN_EPS);
        bf16x8 xb[8];
#pragma unroll
        for (int ks = 0; ks < 8; ++ks) { const f32x4 g0 = *(const f32x4*)(gn + ks * 32 + 8 * g), g1 = *(const f32x4*)(gn + ks * 32 + 8 * g + 4);
            u32x4 o; o.x = pk2(lo16(raw[ks].x) * rstd * g0[0], hi16(raw[ks].x) * rstd * g0[1]); o.y = pk2(lo16(raw[ks].y) * rstd * g0[2], hi16(raw[ks].y) * rstd * g0[3]);
            o.z = pk2(lo16(raw[ks].z) * rstd * g1[0], hi16(raw[ks].z) * rstd * g1[1]); o.w = pk2(lo16(raw[ks].w) * rstd * g1[2], hi16(raw[ks].w) * rstd * g1[3]);
            xb[ks] = __builtin_bit_cast(bf16x8, o); }
#pragma unroll 2
        for (int nt = 0; nt < 8; ++nt) { const int ntile = nt0 + nt;
            const bf16_t* wr = W + (size_t)(ntile * 16 + lr) * 256 + 8 * lp;
            f32x4 d = {0.f, 0.f, 0.f, 0.f};
#pragma unroll
            for (int ks = 0; ks < 8; ++ks) { const bf16x8 a = __builtin_bit_cast(bf16x8, pg8::lperm4(*(const u32x4*)(wr + ks * 32), psrc)); d = __builtin_amdgcn_mfma_f32_16x16x32_bf16(a, xb[ks], d, 0, 0, 0); }
            const unsigned pk = pk4_fp8(fminf(fmaxf(d[0], -440.f), 440.f), fminf(fmaxf(d[1], -440.f), 440.f), fminf(fmaxf(d[2], -440.f), 440.f), fminf(fmaxf(d[3], -440.f), 440.f));
            *(unsigned*)((unsigned char*)kv + (size_t)(t0 + lr) * 256 + ntile * 16 + 4 * lp) = (unsigned)__builtin_amdgcn_ds_bpermute((lr + 16 * lp) << 2, (int)pk);
        }
    }
}

namespace ml {
constexpr int QS = 0, KS = 17408, VS0 = 34816, VSZ = 11264, PS0 = VS0 + 2 * VSZ, PSZ = 9216, CT = PS0 + 2 * PSZ, TB = CT + 21760, TF = TB + 8192, TA = TF + 8192, TI = TA + 8192, TE = TI + 8192, SC = TE + 8192;
constexpr int QLD = 136, VLD = 88, PLD = 72, CTLD = 136;
static_assert(SC + 1024 <= LDS_BYTES - LDS_P, "mlstm lds");
}
__device__ __forceinline__ float scan_sum(float v, int lane) {
#pragma unroll
    for (int o = 1; o < 64; o <<= 1) { const float t = shl_(v, lane >= o ? lane - o : lane); if (lane >= o) v += t; }
    return v;
}
__device__ __forceinline__ float scan_max(float v, int lane) {
#pragma unroll
    for (int o = 1; o < 64; o <<= 1) { const float t = shl_(v, lane >= o ? lane - o : lane); if (lane >= o) v = fmaxf(v, t); }
    return v;
}
__device__ __forceinline__ s16x4 trrd(const LAS unsigned char* p) { return __builtin_amdgcn_ds_read_tr16_b64_v4i16((LAS s16x4*)p); }
__device__ __forceinline__ void mlstm_unit(const Ctx& F0, int l, int unit, int dry) {
    PHASE_ENTER();
    using namespace ml;
    const int b = unit >> 5, h = (unit >> 2) & 7, dq = unit & 3;
    bf16_t* proj = (bf16_t*)(ws + WS_PROJ);
    LAS unsigned char* P = F.P;
    LAS bf16_t* Qs = (LAS bf16_t*)(P + QS); LAS bf16_t* Ks = (LAS bf16_t*)(P + KS); LAS bf16_t* Ct = (LAS bf16_t*)(P + CT);
    LAS float* tB = (LAS float*)(P + TB); LAS float* tF = (LAS float*)(P + TF); LAS float* tA = (LAS float*)(P + TA); LAS float* tI = (LAS float*)(P + TI); LAS float* tE = (LAS float*)(P + TE);
    LAS float* sc = (LAS float*)(P + SC);
    const int tid = F.tid, lane = F.lane, w = F.wave, n16 = lane & 15, g = lane >> 4, qr = (lane & 15) >> 2, pr = lane & 3;
    const float ib = PIN(I_MIB)[l * 8 + h], fb = PIN(I_MFB)[l * 8 + h];
    const size_t rowb = (size_t)b * SEQ;
    for (int c = w; c < 32; c += 8) {
        const size_t t = rowb + c * 64 + lane;
        const float li = bf2f(proj[t * LDP + C_MI + h]) + ib;
        const float x = bf2f(proj[t * LDP + C_MF + h]) + fb;
        const float lf = fminf(x, 0.f) - log1pf(__expf(-fabsf(x)));
        const float bc = scan_sum(lf, lane);
        const float blast = shl_(bc, 63);
        const float Bv = li - bc;
        const float pm = scan_max(Bv, lane);
        const float maxB = shl_(pm, 63);
        tB[c * 64 + lane] = Bv; tF[c * 64 + lane] = __expf(Bv - maxB); tA[c * 64 + lane] = bc; tI[c * 64 + lane] = pm;
        if (lane == 0) { sc[c] = blast; sc[32 + c] = blast + maxB; }
    }
    for (int i = tid; i < 80 * CTLD / 2; i += 512) ((LAS unsigned*)Ct)[i] = 0u;
    for (int i = tid; i < 2 * 64 * 8; i += 512) { const int bufi = i >> 9, row = (i >> 3) & 63, cw = i & 7; ((LAS unsigned*)(P + VS0 + bufi * VSZ + row * VLD * 2 + 128))[cw] = 0x3f803f80u; }
    __syncthreads();
    if (tid == 0) { float m = 0.f;
        for (int c = 0; c < 32; ++c) { const float bl = sc[c], ae = sc[32 + c]; sc[64 + c] = m; const float mn = fmaxf(bl + m, ae); sc[96 + c] = __expf(bl + m - mn); sc[128 + c] = __expf(ae - mn); m = mn; } }
    __syncthreads();
    for (int c = w; c < 32; c += 8) {
        const float bc = tA[c * 64 + lane], pm = tI[c * 64 + lane], mp = sc[64 + c];
        const float mrow = fmaxf(bc + mp, bc + pm);
        tA[c * 64 + lane] = bc - mrow; tI[c * 64 + lane] = __expf(bc + mp - mrow); tE[c * 64 + lane] = __expf(-mrow);
    }
    const float qscale = 0.08838834764831845f;
    f32x4 Cst[5];
#pragma unroll
    for (int i = 0; i < 5; ++i) Cst[i] = (f32x4){0.f, 0.f, 0.f, 0.f};
    const int jt = w & 3, hp = w >> 2;
    const int srow0 = tid >> 4, sch = tid & 15, vrow = tid >> 3, vch = tid & 7;
    u32x4 rq[2], rk[2], rv;
#define ML_LOAD(cc) do { const size_t tb_ = rowb + (size_t)(cc) * 64; \
        _Pragma("unroll") for (int i = 0; i < 2; ++i) { rq[i] = *(const u32x4*)(proj + (tb_ + srow0 + 32 * i) * LDP + C_MQ + h * 128 + sch * 8); rk[i] = *(const u32x4*)(proj + (tb_ + srow0 + 32 * i) * LDP + C_MK + h * 128 + sch * 8); } \
        rv = *(const u32x4*)(proj + (tb_ + vrow) * LDP + C_MV + h * 256 + dq * 64 + vch * 8); } while (0)
    ML_LOAD(0);
    __syncthreads();
#pragma unroll 1
    for (int c = 0; c < 32; ++c) {
        const size_t tb = rowb + c * 64;
        LAS unsigned char* Vb = P + VS0 + (c & 1) * VSZ; LAS bf16_t* Ps = (LAS bf16_t*)(P + PS0 + (c & 1) * PSZ);
#pragma unroll
        for (int i = 0; i < 2; ++i) { *(LAS u32x4*)(Qs + (srow0 + 32 * i) * QLD + sch * 8) = rq[i]; *(LAS u32x4*)(Ks + (srow0 + 32 * i) * QLD + sch * 8) = rk[i]; }
        *(LAS u32x4*)(Vb + vrow * VLD * 2 + vch * 16) = rv;
        unsigned short mo[2][4];
#pragma unroll
        for (int r = 0; r < 4; ++r)
#pragma unroll
            for (int i = 0; i < 2; ++i) mo[i][r] = proj[(tb + jt * 16 + 4 * g + r) * LDP + C_MO + h * 256 + dq * 64 + (2 * hp + i) * 16 + n16];
        if (c + 1 < 32) ML_LOAD(c + 1);
        __syncthreads();
#pragma unroll
        for (int x = 0; x < 2; ++x) { const int st = 2 * hp + x;
            f32x4 d = {0.f, 0.f, 0.f, 0.f};
#pragma unroll
            for (int ks = 0; ks < 4; ++ks) { const bf16x8 a = *(const LAS bf16x8*)(Ks + (st * 16 + n16) * QLD + ks * 32 + 8 * g); const bf16x8 bq = *(const LAS bf16x8*)(Qs + (jt * 16 + n16) * QLD + ks * 32 + 8 * g);
                d = __builtin_amdgcn_mfma_f32_16x16x32_bf16(a, bq, d, 0, 0, 0); }
            const int j = jt * 16 + n16; const float Aj = tA[c * 64 + j];
            const f32x4 b4 = *(const LAS f32x4*)(tB + c * 64 + st * 16 + 4 * g);
            float o[4];
#pragma unroll
            for (int r = 0; r < 4; ++r) { const int s_ = st * 16 + 4 * g + r; o[r] = (s_ <= j) ? __expf(Aj + b4[r]) * d[r] * qscale : 0.f; }
            u32x2 wv; wv.x = pk2(o[0], o[1]); wv.y = pk2(o[2], o[3]);
            *(LAS u32x2*)(Ps + j * PLD + st * 16 + 4 * g) = wv; }
        f32x4 acc5[3];
#pragma unroll
        for (int i = 0; i < 3; ++i) { const int dt = (i < 2) ? (2 * hp + i) : 4;
            f32x4 d = {0.f, 0.f, 0.f, 0.f};
#pragma unroll
            for (int ks = 0; ks < 4; ++ks) { const bf16x8 a = *(const LAS bf16x8*)(Qs + (jt * 16 + n16) * QLD + ks * 32 + 8 * g); const bf16x8 bc = *(const LAS bf16x8*)(Ct + (dt * 16 + n16) * CTLD + ks * 32 + 8 * g);
                d = __builtin_amdgcn_mfma_f32_16x16x32_bf16(a, bc, d, 0, 0, 0); }
            acc5[i] = d; }
        { const float dec = sc[96 + c], scl = sc[128 + c];
            f32x4 dn[5];
#pragma unroll
            for (int dt = 0; dt < 5; ++dt) dn[dt] = (f32x4){0.f, 0.f, 0.f, 0.f};
#pragma unroll
            for (int ks = 0; ks < 2; ++ks) { const int s0 = ks * 32 + 8 * g;
                const LAS unsigned char* ka = (const LAS unsigned char*)Ks + (s0 + qr) * QLD * 2 + (w * 16 + 4 * pr) * 2;
                const s16x4 k0 = trrd(ka), k1 = trrd(ka + 4 * QLD * 2);
                const f32x4 f0 = *(const LAS f32x4*)(tF + c * 64 + s0), f1 = *(const LAS f32x4*)(tF + c * 64 + s0 + 4);
                u32x4 aw; aw.x = pk2(bf2f((unsigned short)k0[0]) * f0[0], bf2f((unsigned short)k0[1]) * f0[1]); aw.y = pk2(bf2f((unsigned short)k0[2]) * f0[2], bf2f((unsigned short)k0[3]) * f0[3]);
                aw.z = pk2(bf2f((unsigned short)k1[0]) * f1[0], bf2f((unsigned short)k1[1]) * f1[1]); aw.w = pk2(bf2f((unsigned short)k1[2]) * f1[2], bf2f((unsigned short)k1[3]) * f1[3]);
                const bf16x8 a = __builtin_bit_cast(bf16x8, aw);
#pragma unroll
                for (int dt = 0; dt < 5; ++dt) { const LAS unsigned char* va = Vb + (s0 + qr) * VLD * 2 + (dt * 16 + 4 * pr) * 2;
                    const s16x4 v0 = trrd(va), v1 = trrd(va + 4 * VLD * 2);
                    const bf16x8 bv = __builtin_shufflevector(v0, v1, 0, 1, 2, 3, 4, 5, 6, 7);
                    dn[dt] = __builtin_amdgcn_mfma_f32_16x16x32_bf16(a, bv, dn[dt], 0, 0, 0); } }
#pragma unroll
            for (int dt = 0; dt < 5; ++dt) Cst[dt] = Cst[dt] * dec + dn[dt] * scl; }
        __syncthreads();
#pragma unroll
        for (int dt = 0; dt < 5; ++dt) { u32x2 wv; wv.x = pk2(Cst[dt][0], Cst[dt][1]); wv.y = pk2(Cst[dt][2], Cst[dt][3]); *(LAS u32x2*)(Ct + (dt * 16 + n16) * CTLD + w * 16 + 4 * g) = wv; }
        f32x4 acc4[3];
#pragma unroll
        for (int i = 0; i < 3; ++i) { const int dt = (i < 2) ? (2 * hp + i) : 4;
            f32x4 d = {0.f, 0.f, 0.f, 0.f};
#pragma unroll
            for (int ks = 0; ks < 2; ++ks) { const int s0 = ks * 32 + 8 * g;
                const bf16x8 a = *(const LAS bf16x8*)(Ps + (jt * 16 + n16) * PLD + ks * 32 + 8 * g);
                const LAS unsigned char* va = Vb + (s0 + qr) * VLD * 2 + (dt * 16 + 4 * pr) * 2;
                const s16x4 v0 = trrd(va), v1 = trrd(va + 4 * VLD * 2);
                const bf16x8 bv = __builtin_shufflevector(v0, v1, 0, 1, 2, 3, 4, 5, 6, 7);
                d = __builtin_amdgcn_mfma_f32_16x16x32_bf16(a, bv, d, 0, 0, 0); }
            acc4[i] = d; }
#pragma unroll
        for (int r = 0; r < 4; ++r) { const int j = jt * 16 + 4 * g + r; const float iw = tI[c * 64 + j] * qscale; const float den = iw * acc5[2][r] + acc4[2][r];
            const float dn_ = fmaxf(fabsf(den), tE[c * 64 + j]); const float inv = 1.0f / dn_;
#pragma unroll
            for (int i = 0; i < 2; ++i) { const float num = iw * acc5[i][r] + acc4[i][r]; const float hv = num * inv;
                bf16_t* op = proj + (tb + j) * LDP + C_MO + h * 256 + dq * 64 + (2 * hp + i) * 16 + n16;
                const float yv = hv * sigmoidf_(bf2f(mo[i][r])); (void)op;
                if (!dry || yv == 1.2345e30f) { const float yc = fminf(fmaxf(yv * 0.5f, -440.f), 440.f);
                    *(unsigned char*)(ws + WS_YM8 + (tb + j) * D + h * 256 + dq * 64 + (2 * hp + i) * 16 + n16) = (unsigned char)(__builtin_amdgcn_cvt_pk_fp8_f32(yc, yc, 0, false) & 0xff); } } }
    }
#undef ML_LOAD
    __syncthreads();
}

namespace at {
constexpr int S_OFF = 0, Q_OFF = 65536, QPITCH = 2080, L_OFF = Q_OFF + 16 * QPITCH, W_OFF = L_OFF + 8192, C_OFF = W_OFF + 1024, QL_OFF = C_OFF + 64, QLP = 288;
static_assert(QL_OFF + 16 * QLP <= LDS_BYTES - LDS_P && (L_OFF % 16) == 0 && (QL_OFF % 16) == 0, "att lds");
}
__device__ __forceinline__ int cnt8_ge(unsigned k0, unsigned k1, unsigned k2, unsigned k3, unsigned k4, unsigned k5, unsigned k6, unsigned k7, unsigned cand) {
    unsigned long long m0, m1, m2, m3, m4, m5, m6, m7;
    asm("v_cmp_ge_u32_e64 %0, %8, %16\n\tv_cmp_ge_u32_e64 %1, %9, %16\n\tv_cmp_ge_u32_e64 %2, %10, %16\n\tv_cmp_ge_u32_e64 %3, %11, %16\n\t"
        "v_cmp_ge_u32_e64 %4, %12, %16\n\tv_cmp_ge_u32_e64 %5, %13, %16\n\tv_cmp_ge_u32_e64 %6, %14, %16\n\tv_cmp_ge_u32_e64 %7, %15, %16\n\ts_nop 1"
        : "=s"(m0), "=s"(m1), "=s"(m2), "=s"(m3), "=s"(m4), "=s"(m5), "=s"(m6), "=s"(m7)
        : "v"(k0), "v"(k1), "v"(k2), "v"(k3), "v"(k4), "v"(k5), "v"(k6), "v"(k7), "v"(cand));
    return __builtin_popcountll(m0) + __builtin_popcountll(m1) + __builtin_popcountll(m2) + __builtin_popcountll(m3) + __builtin_popcountll(m4) + __builtin_popcountll(m5) + __builtin_popcountll(m6) + __builtin_popcountll(m7);
}
__device__ __forceinline__ void att_unit(const Ctx& F0, int b, int qt, int dry, int stop) {
    PHASE_ENTER();
    using namespace at;
    bf16_t* proj = (bf16_t*)(ws + WS_PROJ);
    const unsigned char* kvb = (const unsigned char*)(ws + WS_KV); constexpr int KVP = 256;
    LAS unsigned char* P = F.P;
    LAS _Float16* S = (LAS _Float16*)(P + S_OFF); LAS unsigned char* IQ = P + Q_OFF; LAS unsigned short* LST = (LAS unsigned short*)(P + L_OFF); LAS float* WT = (LAS float*)(P + W_OFF); LAS int* CN = (LAS int*)(P + C_OFF);
    const int tid = F.tid, lane = F.lane, w = F.wave, n16 = lane & 15, g = lane >> 4;
    const int t0 = qt * 16; const size_t T0 = (size_t)b * SEQ + t0; const size_t rowb = (size_t)b * SEQ;
    if (tid < 256) { const int hh = tid >> 4, q = tid & 15; WT[hh * 16 + q] = bf2f(proj[(T0 + q) * LDP + C_IW + hh]); }
#pragma unroll
    for (int i = 0; i < 4; ++i) { const int id = tid + 512 * i, row = id >> 7, ch = id & 127;
        *(LAS u32x4*)(IQ + row * QPITCH + ch * 16) = *(const u32x4*)(proj + (T0 + row) * LDP + C_IQ + ch * 8); }
    __syncthreads();
    { const int q = tid >> 5, c2 = (tid & 31) * 2; float s0 = 0.f, s1 = 0.f;
#pragma unroll
      for (int hh = 0; hh < 16; ++hh) { const unsigned u = *(const LAS unsigned*)(IQ + q * QPITCH + hh * 128 + c2 * 2); const float wv = WT[hh * 16 + q]; s0 += wv * lo16(u); s1 += wv * hi16(u); }
      const unsigned hi = pk2(s0, s1);
      *(LAS unsigned*)(P + QL_OFF + q * QLP + c2 * 2) = hi;
      *(LAS unsigned*)(P + QL_OFF + q * QLP + 128 + c2 * 2) = pk2(s0 - lo16(hi), s1 - hi16(hi)); }
    __syncthreads();
    const int nkt = qt + 1, ngr = (nkt + 3) >> 2;
    {
        bf16x8 bk[4][2], bkn[4][2];
#define ATT_LOADB(dst, gi_) do { _Pragma("unroll") for (int x = 0; x < 4; ++x) _Pragma("unroll") for (int ks = 0; ks < 2; ++ks) \
            dst[x][ks] = *(const bf16x8*)((const unsigned char*)proj + (unsigned)((((unsigned)rowb + (unsigned)(((gi_) * 4 + x) * 16 + (lane >> 2))) * (unsigned)LDP + (unsigned)(C_IK + ks * 32 + 8 * (lane & 3))) * 2u)); } while (0)
        const int kperm1 = (4 * n16 + g) << 2;
        if (w < ngr) ATT_LOADB(bkn, w);
#pragma unroll 1
        for (int gi = w; gi < ngr; gi += 8) {
            const int gn = (gi + 8 < ngr) ? gi + 8 : gi;
#pragma unroll
            for (int x = 0; x < 4; ++x)
#pragma unroll
                for (int ks = 0; ks < 2; ++ks) { const u32x4 s_ = __builtin_bit_cast(u32x4, bkn[x][ks]); u32x4 d_;
                    d_.x = (unsigned)__builtin_amdgcn_ds_bpermute(kperm1, (int)s_.x); d_.y = (unsigned)__builtin_amdgcn_ds_bpermute(kperm1, (int)s_.y); d_.z = (unsigned)__builtin_amdgcn_ds_bpermute(kperm1, (int)s_.z); d_.w = (unsigned)__builtin_amdgcn_ds_bpermute(kperm1, (int)s_.w);
                    bk[x][ks] = __builtin_bit_cast(bf16x8, d_); }
            ATT_LOADB(bkn, gn);
            f32x4 sacc[4];
            { bf16x8 ql[4];
#pragma unroll
              for (int i = 0; i < 4; ++i) ql[i] = *(const LAS bf16x8*)(P + QL_OFF + n16 * QLP + i * 64 + 16 * g);
#pragma unroll
              for (int x = 0; x < 4; ++x) sacc[x] = __builtin_amdgcn_mfma_f32_16x16x32_bf16(ql[0], bk[x][0], (f32x4){0.f, 0.f, 0.f, 0.f}, 0, 0, 0);
#pragma unroll
              for (int x = 0; x < 4; ++x) sacc[x] = __builtin_amdgcn_mfma_f32_16x16x32_bf16(ql[1], bk[x][1], sacc[x], 0, 0, 0);
#pragma unroll
              for (int x = 0; x < 4; ++x) sacc[x] = __builtin_amdgcn_mfma_f32_16x16x32_bf16(ql[2], bk[x][0], sacc[x], 0, 0, 0);
#pragma unroll
              for (int x = 0; x < 4; ++x) sacc[x] = __builtin_amdgcn_mfma_f32_16x16x32_bf16(ql[3], bk[x][1], sacc[x], 0, 0, 0); }
            bf16x8 qa[2][2]; f32x4 wq[2]; f32x4 dd[2][4];
#define ATT_LDQA(buf, hh_) do { qa[buf][0] = *(const LAS bf16x8*)(IQ + n16 * QPITCH + (hh_) * 128 + 16 * g); qa[buf][1] = *(const LAS bf16x8*)(IQ + n16 * QPITCH + (hh_) * 128 + 64 + 16 * g); } while (0)
#define ATT_LDW(buf, hh_) do { wq[buf] = *(const LAS f32x4*)(WT + (hh_) * 16 + 4 * g); } while (0)
#define ATT_MMA(buf) do { _Pragma("unroll") for (int x = 0; x < 4; ++x) dd[buf][x] = __builtin_amdgcn_mfma_f32_16x16x32_bf16(qa[buf][0], bk[x][0], (f32x4){0.f, 0.f, 0.f, 0.f}, 0, 0, 0); \
            _Pragma("unroll") for (int x = 0; x < 4; ++x) dd[buf][x] = __builtin_amdgcn_mfma_f32_16x16x32_bf16(qa[buf][1], bk[x][1], dd[buf][x], 0, 0, 0); } while (0)
#define ATT_FOLD(buf) do { _Pragma("unroll") for (int x = 0; x < 4; ++x) _Pragma("unroll") for (int r = 0; r < 4; ++r) { float t_ = __builtin_fmaf(wq[buf][r], __builtin_fabsf(dd[buf][x][r]), sacc[x][r]); asm("" : "+v"(t_)); sacc[x][r] = t_; } } while (0)
            ATT_LDQA(0, 0); ATT_LDW(0, 0); ATT_LDQA(1, 1);
            ATT_MMA(0);
#pragma unroll 1
            for (int hp = 0; hp < 7; ++hp) { const int h0 = 2 * hp;
                ATT_MMA(1);
                ATT_LDQA(0, h0 + 2); ATT_LDW(1, h0 + 1);
                ATT_FOLD(0);
                ATT_MMA(0);
                ATT_LDQA(1, h0 + 3); ATT_LDW(0, h0 + 2);
                ATT_FOLD(1);
            }
            ATT_MMA(1); ATT_LDW(1, 15);
            ATT_FOLD(0);
            ATT_FOLD(1);
#undef ATT_LDQA
#undef ATT_LDW
#undef ATT_MMA
#undef ATT_FOLD
#pragma unroll
            for (int x = 0; x < 4; ++x) { const int kt = gi * 4 + x; if (kt < nkt) {
#pragma unroll
                for (int r = 0; r < 4; ++r) S[(4 * g + r) * 2048 + kt * 16 + n16] = (_Float16)sacc[x][r]; } }
        }
#undef ATT_LOADB
    }
    __syncthreads();
    if (stop == 1) return;
    u32x4 qwp[2][4];
#pragma unroll
    for (int qq = 0; qq < 2; ++qq)
#pragma unroll
        for (int j = 0; j < 4; ++j) qwp[qq][j] = *(const u32x4*)(proj + (T0 + 2 * w + qq) * LDP + C_AQ + n16 * 128 + g * 32 + j * 8);
#pragma unroll 1
    for (int qq = 0; qq < 2; ++qq) {
        const int q = 2 * w + qq, t = t0 + q, nv = t + 1;
        LAS unsigned short* lst = LST + q * 256;
        if (nv <= 256) {
#pragma unroll
            for (int i = 0; i < 4; ++i) { const int pos = lane + 64 * i; lst[pos] = (unsigned short)(pos < nv ? pos : 0); }
            if (lane == 0) CN[q] = nv;
        } else {
            unsigned key[32];
            const LAS unsigned short* srow = (const LAS unsigned short*)S + q * 2048;
            const int ng = (nv + 511) >> 9;
#pragma unroll
            for (int G = 0; G < 4; ++G) {
                if (G < ng) {
#pragma unroll
                    for (int j = 8 * G; j < 8 * G + 8; ++j) { const int idx = j * 64 + lane; const unsigned u = srow[idx];
                        const unsigned k = (u & 0x8000u) ? (~u & 0xffffu) : (u | 0x8000u); key[j] = idx < nv ? k : 0u; }
                } else {
#pragma unroll
                    for (int j = 8 * G; j < 8 * G + 8; ++j) key[j] = 0u;
                }
            }
#define ATT_CNT(cand_) (cnt8_ge(key[0], key[1], key[2], key[3], key[4], key[5], key[6], key[7], cand_) + (ng > 1 ? cnt8_ge(key[8], key[9], key[10], key[11], key[12], key[13], key[14], key[15], cand_) : 0) \
                      + (ng > 2 ? cnt8_ge(key[16], key[17], key[18], key[19], key[20], key[21], key[22], key[23], cand_) : 0) + (ng > 3 ? cnt8_ge(key[24], key[25], key[26], key[27], key[28], key[29], key[30], key[31], cand_) : 0))
            unsigned Tk = 0u;
#pragma unroll 1
            for (int bit = 15; bit >= 0; --bit) { const unsigned cand = Tk | (1u << bit);
                const int cge = ATT_CNT(cand);
                if (cge >= 256) Tk = cand;
                if (cge == 256) break; }
            const int cgt = ATT_CNT(Tk + 1u);
#undef ATT_CNT
            int base = 0, tbase = cgt;
#pragma unroll
            for (int G = 0; G < 4; ++G) {
                if (G < ng) {
#pragma unroll
                    for (int j = 8 * G; j < 8 * G + 8; ++j) { const bool sg = key[j] > Tk, st = key[j] == Tk; const unsigned long long m = __ballot(sg), m2 = __ballot(st);
                        const int pg = (int)__builtin_amdgcn_mbcnt_hi((unsigned)(m >> 32), __builtin_amdgcn_mbcnt_lo((unsigned)m, (unsigned)base));
                        const int pe = (int)__builtin_amdgcn_mbcnt_hi((unsigned)(m2 >> 32), __builtin_amdgcn_mbcnt_lo((unsigned)m2, (unsigned)tbase));
                        if (sg || (st && pe < 256)) lst[sg ? pg : pe] = (unsigned short)(j * 64 + lane);
                        base += __builtin_popcountll(m); tbase += __builtin_popcountll(m2); }
                }
            }
            if (lane == 0) CN[q] = 256;
        }
    }
    typedef int v8i_ __attribute__((ext_vector_type(8)));
    v8i_ qf8p[2];
#pragma unroll
    for (int qq = 0; qq < 2; ++qq)
#pragma unroll
        for (int j = 0; j < 4; ++j) { const u32x4 v = qwp[qq][j]; qf8p[qq][2 * j] = (int)pk4_fp8(lo16(v.x), hi16(v.x), lo16(v.y), hi16(v.y)); qf8p[qq][2 * j + 1] = (int)pk4_fp8(lo16(v.z), hi16(v.z), lo16(v.w), hi16(v.w)); }
    __syncthreads();
    if (stop == 2) return;
    LAS unsigned char* VS = P + S_OFF + w * 8192;
    const unsigned rowb32 = (unsigned)rowb;
    const int qr = (lane & 15) >> 2, pr = lane & 3;
#pragma unroll 1
    for (int qq = 0; qq < 2; ++qq) {
        const int q = 2 * w + qq, t = t0 + q; const int cnt = __builtin_amdgcn_readfirstlane(CN[q]);
        const LAS unsigned short* lst = LST + q * 256;
        bf16_t* qrow = proj + (T0 + q) * LDP + C_AQ;
#ifdef ATT_SKIP3
        { for (int c = lane; c < 2048; c += 64) qrow[c] = (bf16_t)f2bf((float)lst[c & 255] * 1e-3f + (float)cnt * 1e-3f); continue; }
#endif
        v8i_ qf8;
#pragma unroll
        for (int j = 0; j < 8; ++j) qf8[j] = qq ? qf8p[1][j] : qf8p[0][j];
        const float scale = 0.08838834764831845f;
        const float slope2 = exp2f(-0.5f * (float)(n16 + 1)) * 11.313708498984761f;
        f32x4 lg[16];
#ifndef ATT_KB
#define ATT_KB 8
#endif
        u32x4 kf[2][ATT_KB][2];
        const int kperm = (4 * n16 + g) << 2;
#define ATT_LOADK(bt, buf) do { _Pragma("unroll") for (int x = 0; x < ATT_KB; ++x) { const unsigned sidx = lst[((bt) * ATT_KB + x) * 16 + (lane >> 2)]; const unsigned char* kr = kvb + (unsigned)((rowb32 + sidx) * 256u + (unsigned)(lane & 3) * 32u); \
            kf[buf][x][0] = *(const u32x4*)kr; kf[buf][x][1] = *(const u32x4*)(kr + 16); } } while (0)
        ATT_LOADK(0, 0); ATT_LOADK(1, 1);
        __builtin_amdgcn_sched_barrier(0);
#pragma unroll
        for (int bt = 0; bt < 16 / ATT_KB; ++bt) {
#pragma unroll
            for (int x = 0; x < ATT_KB; ++x) { const int kt2 = bt * ATT_KB + x;
                typedef int v4i_ __attribute__((ext_vector_type(4)));
                const u32x4 ka = kf[bt & 1][x][0], kb = kf[bt & 1][x][1]; v8i_ k8;
                k8[0] = __builtin_amdgcn_ds_bpermute(kperm, (int)ka.x); k8[1] = __builtin_amdgcn_ds_bpermute(kperm, (int)ka.y); k8[2] = __builtin_amdgcn_ds_bpermute(kperm, (int)ka.z); k8[3] = __builtin_amdgcn_ds_bpermute(kperm, (int)ka.w);
                k8[4] = __builtin_amdgcn_ds_bpermute(kperm, (int)kb.x); k8[5] = __builtin_amdgcn_ds_bpermute(kperm, (int)kb.y); k8[6] = __builtin_amdgcn_ds_bpermute(kperm, (int)kb.z); k8[7] = __builtin_amdgcn_ds_bpermute(kperm, (int)kb.w);
                const f32x4 d = __builtin_amdgcn_mfma_scale_f32_16x16x128_f8f6f4(k8, qf8, (f32x4){0.f, 0.f, 0.f, 0.f}, 0, 0, 0, 0x7f7f7f7f, 0, 0x7f7f7f7f);
                const u32x2 sw = *(const LAS u32x2*)(lst + kt2 * 16 + 4 * g);
                const int s0 = sw.x & 0xffff, s1 = sw.x >> 16, s2 = sw.y & 0xffff, s3 = sw.y >> 16; const int pos = kt2 * 16 + 4 * g;
                f32x4 lv; (void)pos;
                lv[0] = __builtin_fmaf(-slope2, (float)(t - s0), d[0]);
                lv[1] = __builtin_fmaf(-slope2, (float)(t - s1), d[1]);
                lv[2] = __builtin_fmaf(-slope2, (float)(t - s2), d[2]);
                lv[3] = __builtin_fmaf(-slope2, (float)(t - s3), d[3]);
                lg[kt2] = lv; }
        }
        if (cnt < 256) {
            asm volatile("" ::: "memory");
#pragma unroll
            for (int i = 0; i < 16; ++i)
#pragma unroll
                for (int r = 0; r < 4; ++r) lg[i][r] = (i * 16 + 4 * g + r < cnt) ? lg[i][r] : -INFINITY;
        }
#undef ATT_LOADK
        u32x4 vv[8][4];
#define ATT_LOADV(pp, buf) do { _Pragma("unroll") for (int i = 0; i < 4; ++i) { const int row = (lane >> 3) + 8 * i; const unsigned sidx = lst[32 * (pp) + row]; vv[buf][i] = *(const u32x4*)(kvb + (unsigned)((rowb32 + sidx) * 256u + 128u + (unsigned)(lane & 7) * 16u)); } } while (0)
        asm volatile("" ::: "memory");
#pragma unroll
        for (int pp = 0; pp < 6; ++pp) ATT_LOADV(pp, pp);
        float mx = -INFINITY;
#pragma unroll
        for (int i = 0; i < 16; ++i) mx = fmaxf(mx, fmaxf(fmaxf(lg[i][0], lg[i][1]), fmaxf(lg[i][2], lg[i][3])));
        mx = fmaxf(mx, shx(mx, 16, lane)); mx = fmaxf(mx, shx(mx, 32, lane));
        float sum = 0.f;
        const float c1 = scale * 1.4426950408889634f, nmx = -mx * c1;
#pragma unroll
        for (int i = 0; i < 16; ++i) {
#pragma unroll
            for (int r = 0; r < 4; ++r) { const float e = __builtin_amdgcn_exp2f(__builtin_fmaf(lg[i][r], c1, nmx)); lg[i][r] = e; sum += e; } }
        sum += shx(sum, 16, lane); sum += shx(sum, 32, lane);
        const float inv = 1.0f / sum;
        bf16x8 pf[8];
#pragma unroll
        for (int pp = 0; pp < 8; ++pp) { u32x4 o; o.x = pk2(lg[2 * pp][0] * inv, lg[2 * pp][1] * inv); o.y = pk2(lg[2 * pp][2] * inv, lg[2 * pp][3] * inv);
            o.z = pk2(lg[2 * pp + 1][0] * inv, lg[2 * pp + 1][1] * inv); o.w = pk2(lg[2 * pp + 1][2] * inv, lg[2 * pp + 1][3] * inv); pf[pp] = __builtin_bit_cast(bf16x8, o); }
        asm volatile("" ::: "memory");
        ATT_LOADV(6, 6); ATT_LOADV(7, 7);
        f32x4 oacc[8];
#pragma unroll
        for (int dt = 0; dt < 8; ++dt) oacc[dt] = (f32x4){0.f, 0.f, 0.f, 0.f};
#pragma unroll
        for (int pp = 0; pp < 8; ++pp) {
            asm volatile("" ::: "memory");
#pragma unroll
            for (int i = 0; i < 4; ++i) { const int row = (lane >> 3) + 8 * i; const u32x4 w8 = vv[pp][i];
                u32x4 b0, b1; b0.x = bf2_fp8(w8.x, false); b0.y = bf2_fp8(w8.x, true); b0.z = bf2_fp8(w8.y, false); b0.w = bf2_fp8(w8.y, true); b1.x = bf2_fp8(w8.z, false); b1.y = bf2_fp8(w8.z, true); b1.z = bf2_fp8(w8.w, false); b1.w = bf2_fp8(w8.w, true);
                LAS unsigned char* vp = VS + row * 256 + ((((lane & 7) ^ (row & 7))) << 5);
                *(LAS u32x4*)vp = b0; *(LAS u32x4*)(vp + 16) = b1; }
            const int row1 = 4 * g + qr;
#pragma unroll
            for (int dt = 0; dt < 8; ++dt) {
                const LAS unsigned char* a1 = VS + row1 * 256 + ((dt ^ (row1 & 7)) << 5) + 8 * pr;
                const s16x4 lo = __builtin_amdgcn_ds_read_tr16_b64_v4i16((LAS s16x4*)a1);
                const s16x4 hi = __builtin_amdgcn_ds_read_tr16_b64_v4i16((LAS s16x4*)(a1 + 16 * 256));
                const bf16x8 vf = __builtin_shufflevector(lo, hi, 0, 1, 2, 3, 4, 5, 6, 7);
                oacc[dt] = __builtin_amdgcn_mfma_f32_16x16x32_bf16(vf, pf[pp], oacc[dt], 0, 0, 0);
            }
        }
#undef ATT_LOADV
#pragma unroll
        for (int dt = 0; dt < 8; ++dt) *(LAS unsigned*)(VS + n16 * 128 + ((dt ^ (n16 & 7)) << 4) + 4 * g) = pk4_fp8(oacc[dt][0], oacc[dt][1], oacc[dt][2], oacc[dt][3]);
        { const int hr = lane >> 2, pb = (lane & 3) * 2;
          const u32x4 o0 = *(const LAS u32x4*)(VS + hr * 128 + ((pb ^ (hr & 7)) << 4)), o1 = *(const LAS u32x4*)(VS + hr * 128 + (((pb + 1) ^ (hr & 7)) << 4));
          unsigned char* yr = ws + WS_HB8 + (T0 + q) * D + lane * 32;
          if (!dry || o0.x == 0x12345678u) { *(u32x4*)yr = o0; *(u32x4*)(yr + 16) = o1; } }
    }
    __syncthreads();
}

namespace l1 {
constexpr int HH = 0, HL = 65792, LG = 131584, RI = LG + 2048, LC = RI + 2048, LB = LC + 64;
constexpr int HLD = 2056;
static_assert(LB + 64 <= LDS_BYTES - LDS_P, "ln1 lds");
}
__device__ __forceinline__ void phase_ln1(const Ctx& F0, int l) {
    PHASE_ENTER();
    using namespace l1;
    LAS unsigned char* P = F.P;
    LAS bf16_t* Hh = (LAS bf16_t*)(P + HH); LAS bf16_t* Hl = (LAS bf16_t*)(P + HL); LAS float* RED = (LAS float*)(P + HH);
    LAS float* Lg = (LAS float*)(P + LG); LAS int* Ri = (LAS int*)(P + RI); LAS int* Lc = (LAS int*)(P + LC); LAS int* Lb = (LAS int*)(P + LB);
    const bf16_t* PRE = (const bf16_t*)(ws + WS_PRE); bf16_t* HB = (bf16_t*)(ws + WS_HB);
    const bf16_t* WRH = (const bf16_t*)(ws + WS_WRH); const bf16_t* WRL = (const bf16_t*)(ws + WS_WRL);
    const float* gam = q_->in[I_LN1G] + l * D; const float* bet = q_->in[I_LN1B] + l * D;
    const float* bgrp = q_->in[I_BGRP] + l * 4; const float* bexp = q_->in[I_BEXP] + l * 16;
    unsigned* gcnt = ctl + CW_CNT + l * 1024;
    int* LIST = (int*)(ws + WS_LIST); float* WL = (float*)(ws + WS_WL); int* TOK = (int*)(ws + WS_TOK);
    const int tid = F.tid, lane = F.lane, w = F.wave, n16 = lane & 15, g = lane >> 4;
    if (tid < 16) Lc[tid] = 0;
    __syncthreads();
    const int rbase = F.vcu * 64;
    bf16x8 rbh0[8], rbh1[8];
    const int rpsrc = (4 * n16 + g) << 2; const int rlr = lane >> 2, rlp = lane & 3;
#pragma unroll
    for (int kk = 0; kk < 8; ++kk) { const int ks = 8 * w + kk; const size_t o0 = (size_t)rlr * 2048 + ks * 32 + 8 * rlp, o1 = (size_t)(16 + rlr) * 2048 + ks * 32 + 8 * rlp;
        rbh0[kk] = __builtin_bit_cast(bf16x8, pg8::lperm4(*(const u32x4*)(WRH + o0), rpsrc)); rbh1[kk] = __builtin_bit_cast(bf16x8, pg8::lperm4(*(const u32x4*)(WRH + o1), rpsrc)); }
    for (int it = 0; it < 4; ++it) {
#pragma unroll 1
        for (int rr = 0; rr < 2; ++rr) { const int r16 = 2 * w + rr; const size_t t = (size_t)rbase + it * 16 + r16;
            const u32x4* xr = (const u32x4*)(PRE + t * D) + lane;
            float v[4][8]; float s = 0.f;
#pragma unroll
            for (int j = 0; j < 4; ++j) { const u32x4 x = __builtin_nontemporal_load(xr + 64 * j);
                v[j][0] = lo16(x.x); v[j][1] = hi16(x.x); v[j][2] = lo16(x.y); v[j][3] = hi16(x.y); v[j][4] = lo16(x.z); v[j][5] = hi16(x.z); v[j][6] = lo16(x.w); v[j][7] = hi16(x.w);
#pragma unroll
                for (int e = 0; e < 8; ++e) s += v[j][e]; }
            const float mean = wave_sum(s, lane) * (1.0f / D); float s2 = 0.f;
#pragma unroll
            for (int j = 0; j < 4; ++j)
#pragma unroll
                for (int e = 0; e < 8; ++e) { v[j][e] -= mean; s2 += v[j][e] * v[j][e]; }
            const float rstd = 1.0f / sqrtf(wave_sum(s2, lane) * (1.0f / D) + LN_EPS);
#pragma unroll
            for (int j = 0; j < 4; ++j) { const int k0 = 8 * (lane + 64 * j);
                const f32x4 g0 = *(const f32x4*)(gam + k0), g1 = *(const f32x4*)(gam + k0 + 4), b0 = *(const f32x4*)(bet + k0), b1 = *(const f32x4*)(bet + k0 + 4);
                float y[8];
#pragma unroll
                for (int e = 0; e < 4; ++e) { y[e] = v[j][e] * rstd * g0[e] + b0[e]; y[4 + e] = v[j][4 + e] * rstd * g1[e] + b1[e]; }
                u32x4 hi; hi.x = pk2(y[0], y[1]); hi.y = pk2(y[2], y[3]); hi.z = pk2(y[4], y[5]); hi.w = pk2(y[6], y[7]);
                *((u32x4*)(HB + t * D) + lane + 64 * j) = hi;
                { u32x2 o8; o8.x = pk4_fp8(y[0], y[1], y[2], y[3]); o8.y = pk4_fp8(y[4], y[5], y[6], y[7]); *((u32x2*)(ws + WS_HB8 + t * D) + lane + 64 * j) = o8; }
                u32x4 lo; lo.x = pk2(y[0] - lo16(hi.x), y[1] - hi16(hi.x)); lo.y = pk2(y[2] - lo16(hi.y), y[3] - hi16(hi.y)); lo.z = pk2(y[4] - lo16(hi.z), y[5] - hi16(hi.z)); lo.w = pk2(y[6] - lo16(hi.w), y[7] - hi16(hi.w));
                *(LAS u32x4*)(Hh + r16 * HLD + k0) = hi; *(LAS u32x4*)(Hl + r16 * HLD + k0) = lo; }
        }
        __syncthreads();
        f32x4 d0 = {0.f, 0.f, 0.f, 0.f}, d1 = {0.f, 0.f, 0.f, 0.f};
#pragma unroll
        for (int kk = 0; kk < 8; ++kk) { const int ks = 8 * w + kk;
            const bf16x8 ah = *(const LAS bf16x8*)(Hh + n16 * HLD + ks * 32 + 8 * g), al = *(const LAS bf16x8*)(Hl + n16 * HLD + ks * 32 + 8 * g);
            const size_t o0 = (size_t)rlr * 2048 + ks * 32 + 8 * rlp, o1 = (size_t)(16 + rlr) * 2048 + ks * 32 + 8 * rlp;
            const bf16x8 bh0 = rbh0[kk], bh1 = rbh1[kk];
            const bf16x8 bl0 = __builtin_bit_cast(bf16x8, pg8::lperm4(*(const u32x4*)(WRL + o0), rpsrc)), bl1 = __builtin_bit_cast(bf16x8, pg8::lperm4(*(const u32x4*)(WRL + o1), rpsrc));
            d0 = __builtin_amdgcn_mfma_f32_16x16x32_bf16(ah, bh0, d0, 0, 0, 0); d0 = __builtin_amdgcn_mfma_f32_16x16x32_bf16(ah, bl0, d0, 0, 0, 0); d0 = __builtin_amdgcn_mfma_f32_16x16x32_bf16(al, bh0, d0, 0, 0, 0);
            d1 = __builtin_amdgcn_mfma_f32_16x16x32_bf16(ah, bh1, d1, 0, 0, 0); d1 = __builtin_amdgcn_mfma_f32_16x16x32_bf16(ah, bl1, d1, 0, 0, 0); d1 = __builtin_amdgcn_mfma_f32_16x16x32_bf16(al, bh1, d1, 0, 0, 0); }
        __syncthreads();
#pragma unroll
        for (int r = 0; r < 4; ++r) { RED[w * 512 + (4 * g + r) * 32 + n16] = d0[r]; RED[w * 512 + (4 * g + r) * 32 + 16 + n16] = d1[r]; }
        __syncthreads();
        { float s = 0.f;
#pragma unroll
          for (int k = 0; k < 8; ++k) s += RED[k * 512 + tid];
          Lg[tid] = s; }
        __syncthreads();
        if (tid < 16) { const LAS float* lgr = Lg + tid * 32;
            float g0 = lgr[0] + bgrp[0], g1 = lgr[1] + bgrp[1], g2 = lgr[2] + bgrp[2], g3 = lgr[3] + bgrp[3];
            int gi = 0; float gm = g0; if (g1 > gm) { gm = g1; gi = 1; } if (g2 > gm) { gm = g2; gi = 2; } if (g3 > gm) { gm = g3; gi = 3; }
            const float gp = 1.0f / (expf(g0 - gm) + expf(g1 - gm) + expf(g2 - gm) + expf(g3 - gm));
            const float e0 = lgr[4 + 4 * gi + 0] + bexp[4 * gi + 0], e1 = lgr[4 + 4 * gi + 1] + bexp[4 * gi + 1], e2 = lgr[4 + 4 * gi + 2] + bexp[4 * gi + 2], e3 = lgr[4 + 4 * gi + 3] + bexp[4 * gi + 3];
            int i0 = 0; float m0 = e0; if (e1 > m0) { m0 = e1; i0 = 1; } if (e2 > m0) { m0 = e2; i0 = 2; } if (e3 > m0) { m0 = e3; i0 = 3; }
            int i1 = -1; float m1 = -INFINITY;
            if (i0 != 0 && e0 > m1) { m1 = e0; i1 = 0; } if (i0 != 1 && e1 > m1) { m1 = e1; i1 = 1; } if (i0 != 2 && e2 > m1) { m1 = e2; i1 = 2; } if (i0 != 3 && e3 > m1) { m1 = e3; i1 = 3; }
            if (i1 < 0) i1 = (i0 == 0) ? 1 : 0;
            const float r1 = expf(m1 - m0); const float w0 = gp / (1.0f + r1), w1 = gp * r1 / (1.0f + r1);
            const int ex0 = 4 * gi + i0, ex1 = 4 * gi + i1;
            const int lp0 = atomicAdd((int*)(Lc + ex0), 1), lp1 = atomicAdd((int*)(Lc + ex1), 1);
            LAS int* ri = Ri + (it * 16 + tid) * 8; ri[0] = ex0; ri[1] = ex1; ri[2] = lp0; ri[3] = lp1; ri[4] = __float_as_int(w0); ri[5] = __float_as_int(w1); }
        __syncthreads();
    }
    if (tid < 16) Lb[tid] = (int)__hip_atomic_fetch_add(gcnt + tid * 16, (unsigned)Lc[tid], __ATOMIC_RELAXED, __HIP_MEMORY_SCOPE_AGENT);
    __syncthreads();
    if (tid < 64) { const LAS int* ri = Ri + tid * 8; const int t = rbase + tid; const int ex0 = ri[0], ex1 = ri[1]; const int p0 = Lb[ex0] + ri[2], p1 = Lb[ex1] + ri[3];
        LIST[ex0 * ECAP + p0] = t; LIST[ex1 * ECAP + p1] = t; WL[ex0 * ECAP + p0] = __int_as_float(ri[4]); WL[ex1 * ECAP + p1] = __int_as_float(ri[5]);
        TOK[t * 4 + 0] = ex0; TOK[t * 4 + 1] = p0; TOK[t * 4 + 2] = ex1; TOK[t * 4 + 3] = p1; }
    __syncthreads();
}

__device__ __forceinline__ void moe_tables(const Ctx& F0, int l) {
    PHASE_ENTER();
    if (F.tid == 0) { LAS int* tpre = (LAS int*)(F.lds + 64); LAS int* cn = (LAS int*)(F.lds + 192); unsigned* gcnt = ctl + CW_CNT + l * 1024; int acc = 0;
        for (int e = 0; e < 16; ++e) { const int c = (int)__hip_atomic_load(gcnt + e * 16, __ATOMIC_RELAXED, __HIP_MEMORY_SCOPE_AGENT); cn[e] = c; tpre[e] = acc; acc += (c + 255) >> 8; }
        tpre[16] = acc; }
    __syncthreads();
}

__device__ __forceinline__ void phase_ln2(const Ctx& F0, int l) {
    moe_tables(F0, l);
    PHASE_ENTER();
    const LAS int* tpre = (const LAS int*)(F.lds + 64);
    float* Hout = q_->out; bf16_t* HB = (bf16_t*)(ws + WS_HB); const bf16_t* Y = (const bf16_t*)(ws + WS_Y); const bf16_t* PLE = (const bf16_t*)(ws + WS_PLE);
    const int* TOK = (const int*)(ws + WS_TOK);
    const float* gam = PIN(I_LN2G) + l * D; const float* bet = PIN(I_LN2B) + l * D;
    const int lane = F.lane;
    const int gw = F.vcu * 8 + F.wave, NGW = F.G * 8;
    f32x4 gG[4][2], gB[4][2];
#pragma unroll
    for (int j = 0; j < 4; ++j) { const int k0 = 8 * (lane + 64 * j); gG[j][0] = *(const f32x4*)(gam + k0); gG[j][1] = *(const f32x4*)(gam + k0 + 4); gB[j][0] = *(const f32x4*)(bet + k0); gB[j][1] = *(const f32x4*)(bet + k0 + 4); }
    for (int t = gw; t < T; t += NGW) {
        const int e0 = TOK[t * 4 + 0], p0 = TOK[t * 4 + 1], e1 = TOK[t * 4 + 2], p1 = TOK[t * 4 + 3];
        const size_t s0 = (size_t)tpre[e0] * 256 + p0, s1 = (size_t)tpre[e1] * 256 + p1;
        const u32x4* y0 = (const u32x4*)(Y + s0 * D) + lane; const u32x4* y1 = (const u32x4*)(Y + s1 * D) + lane; const u32x4* pl = (const u32x4*)(PLE + (size_t)t * D) + lane;
        float v[4][8]; float s = 0.f;
#pragma unroll
        for (int j = 0; j < 4; ++j) { const u32x4 a = __builtin_nontemporal_load(y0 + 64 * j), b2 = __builtin_nontemporal_load(y1 + 64 * j), c = __builtin_nontemporal_load(pl + 64 * j);
            v[j][0] = lo16(a.x) + lo16(b2.x) + lo16(c.x); v[j][1] = hi16(a.x) + hi16(b2.x) + hi16(c.x);
            v[j][2] = lo16(a.y) + lo16(b2.y) + lo16(c.y); v[j][3] = hi16(a.y) + hi16(b2.y) + hi16(c.y);
            v[j][4] = lo16(a.z) + lo16(b2.z) + lo16(c.z); v[j][5] = hi16(a.z) + hi16(b2.z) + hi16(c.z);
            v[j][6] = lo16(a.w) + lo16(b2.w) + lo16(c.w); v[j][7] = hi16(a.w) + hi16(b2.w) + hi16(c.w);
#pragma unroll
            for (int e = 0; e < 8; ++e) s += v[j][e]; }
        const float mean = wave_sum(s, lane) * (1.0f / D); float s2 = 0.f;
#pragma unroll
        for (int j = 0; j < 4; ++j)
#pragma unroll
            for (int e = 0; e < 8; ++e) { v[j][e] -= mean; s2 += v[j][e] * v[j][e]; }
        const float rstd = 1.0f / sqrtf(wave_sum(s2, lane) * (1.0f / D) + LN_EPS);
#pragma unroll
        for (int j = 0; j < 4; ++j) { const int k0 = 8 * (lane + 64 * j);
            const f32x4 g0 = gG[j][0], g1 = gG[j][1], b0 = gB[j][0], b1 = gB[j][1];
            f32x4 ya, yb;
#pragma unroll
            for (int e = 0; e < 4; ++e) { ya[e] = v[j][e] * rstd * g0[e] + b0[e]; yb[e] = v[j][4 + e] * rstd * g1[e] + b1[e]; }
#ifdef FP8_SELFTEST
            if (l == 1) { const float fct = ((const float*)ctl)[CW_CNT + 4000]; ya = ya * fct; yb = yb * fct; }
#endif
            if (l == 1) { *(f32x4*)(Hout + (size_t)t * D + k0) = ya; *(f32x4*)(Hout + (size_t)t * D + k0 + 4) = yb; }
            else { u32x4 hi; hi.x = pk2(ya[0], ya[1]); hi.y = pk2(ya[2], ya[3]); hi.z = pk2(yb[0], yb[1]); hi.w = pk2(yb[2], yb[3]); *((u32x4*)(HB + (size_t)t * D) + lane + 64 * j) = hi;
                u32x2 o8; o8.x = pk4_fp8(ya[0], ya[1], ya[2], ya[3]); o8.y = pk4_fp8(yb[0], yb[1], yb[2], yb[3]); *((u32x2*)(ws + WS_HB8 + (size_t)t * D) + lane + 64 * j) = o8;
                } }
    }
}

#define TOKTAB(F) ((LAS unsigned*)((F).lds + LDS_P + 131072))
__device__ __forceinline__ void phase_inproj(const Ctx& F0) {
    PHASE_ENTER();
    { typedef pg8::DenseSched<T, pg8::NFP8, D / 2, D / 2, 0, 1> Sch; Sch S; S.init(F.G, (int)blockIdx.x, ws + WS_HB8, ws + WS_WIN8);
      pg8::EpiStoreBf16NT E{(bf16_t*)(ws + WS_PROJ), LDP};
      pg8::gemm_phase<pg8::EpiStoreBf16NT, Sch, false, true, D / 2, D / 2, D / 2, true>(F.P, F.tid, TOKTAB(F), S, E); }
    { typedef pg8::DenseSched<T, LDP - pg8::NFP8, D, D> Sch; Sch S; S.init(F.G, (int)blockIdx.x, ws + WS_HB, (const bf16_t*)(ws + WS_WIN) + (size_t)pg8::NFP8 * D);
      pg8::EpiStoreBf16NT E{(bf16_t*)(ws + WS_PROJ) + pg8::NFP8, LDP};
      pg8::gemm_phase<pg8::EpiStoreBf16NT, Sch, false, true, D, D, D>(F.P, F.tid, TOKTAB(F), S, E); }
}
__device__ __forceinline__ void phase_mix_a(const Ctx& F0) {
    PHASE_ENTER();
    bf16_t* PROJ = (bf16_t*)(ws + WS_PROJ);
    typedef pg8::DenseSched<T, D, D / 2, D / 2> Sch; Sch S; S.init(F.G, (int)blockIdx.x, ws + WS_HB8, ws + WS_WPA8);
    pg8::EpiGate<false> E{(bf16_t*)(ws + WS_MIX), D, PROJ + C_GA, LDP, nullptr, 0};
    pg8::gemm_phase<pg8::EpiGate<false>, Sch, false, true, D / 2, D / 2, D / 2, true>(F.P, F.tid, TOKTAB(F), S, E);
}
__device__ __forceinline__ void phase_mix_m(const Ctx& F0) {
    PHASE_ENTER();
    bf16_t* PROJ = (bf16_t*)(ws + WS_PROJ);
    typedef pg8::DenseSched<T, D, D / 2, D / 2> Sch; Sch S; S.init(F.G, (int)blockIdx.x, ws + WS_YM8, ws + WS_WPM8);
    pg8::EpiGate<true> E{(bf16_t*)(ws + WS_MIX), D, PROJ + C_GM, LDP, (unsigned char*)(PROJ + C_AQ), LDP * 2};
    pg8::gemm_phase<pg8::EpiGate<true>, Sch, false, true, D / 2, D / 2, D / 2, true, (int)0x80808080, 0x79797979>(F.P, F.tid, TOKTAB(F), S, E);
}
__device__ __forceinline__ void phase_out(const Ctx& F0, int l) {
    PHASE_ENTER();
    typedef pg8::DenseSched<T, D, LDP, D / 2> Sch; Sch S; S.init(F.G, (int)blockIdx.x, ws + WS_PROJ, ws + WS_WOUT8);
    pg8::EpiResBf16 E{(bf16_t*)(ws + WS_PRE), (const bf16_t*)(ws + WS_HB), DN_ALPHA, D};
    pg8::gemm_phase<pg8::EpiResBf16, Sch, false, true, D / 2, LDP, D / 2, true>(F.P, F.tid, TOKTAB(F), S, E);
}
__device__ __forceinline__ void phase_moe_up(const Ctx& F0, int l) {
    moe_tables(F0, l);
    PHASE_ENTER();
    pg8::MoeSched S; S.tpre = (const LAS int*)(F.lds + 64); S.cnt = (const LAS int*)(F.lds + 192); S.NT = 4; S.G = F.G; S.c = (int)blockIdx.x; S.mode = 0;
    S.Abase = (const char*)(ws + WS_HB8); S.Bbase = (const char*)(ws + WS_WGU8); S.list = (const int*)(ws + WS_LIST); S.bshift = 1;
    pg8::EpiSwiglu E{(unsigned char*)(ws + WS_HMID), (const float*)(ws + WS_WL)};
    pg8::gemm_phase<pg8::EpiSwiglu, pg8::MoeSched, true, true, D / 2, D / 2, D / 2, true>(F.P, F.tid, TOKTAB(F), S, E);
}
__device__ __forceinline__ void phase_ple(const Ctx& F0) {
    PHASE_ENTER();
    typedef pg8::DenseSched<T, D, 256, 256> Sch; Sch S; S.init(F.G, (int)blockIdx.x, ws + WS_PB, ws + WS_WPLE);
    pg8::EpiStoreBf16 E{(bf16_t*)(ws + WS_PLE), D};
    pg8::gemm_phase<pg8::EpiStoreBf16, Sch, false, true, 256, 256, 256>(F.P, F.tid, TOKTAB(F), S, E);
}
__device__ __forceinline__ void phase_plegate(const Ctx& F0) {
    PHASE_ENTER();
    typedef pg8::DenseSched<T, D, D / 2, D / 2> Sch; Sch S; S.init(F.G, (int)blockIdx.x, ws + WS_HB8, ws + WS_WPG8);
    pg8::EpiPleGate E{(bf16_t*)(ws + WS_PLE), D, (const bf16_t*)(ws + WS_HB), DN_ALPHA};
    pg8::gemm_phase<pg8::EpiPleGate, Sch, false, true, D / 2, D / 2, D / 2, true>(F.P, F.tid, TOKTAB(F), S, E);
}
__device__ __forceinline__ void phase_moe_down(const Ctx& F0, int l) {
    moe_tables(F0, l);
    PHASE_ENTER();
    pg8::MoeSched S; S.tpre = (const LAS int*)(F.lds + 64); S.cnt = (const LAS int*)(F.lds + 192); S.NT = 8; S.G = F.G; S.c = (int)blockIdx.x; S.mode = 1; S.bshift = 1;
    S.Abase = (const char*)(ws + WS_HMID); S.Bbase = (const char*)(ws + WS_WD8); S.list = nullptr;
    pg8::EpiStoreBf16NT E{(bf16_t*)(ws + WS_Y), D};
    pg8::gemm_phase<pg8::EpiStoreBf16NT, pg8::MoeSched, false, true, 256, 256, 256, true, 0x7b7b7b7b, 0x79797979>(F.P, F.tid, TOKTAB(F), S, E);
}
__device__ __forceinline__ void phase_mixers(const Ctx& F0, int l, int dry, int conv) {
    const int b = F0.vcu >> 5, j = F0.vcu & 31, slot = F0.vcu % 5;
#pragma unroll 1
    for (int st = 0; st < 5; ++st) {
        if (conv && st == slot) { phase_convert(F0, l, 1); __syncthreads(); }
        if (st == 0) mlstm_unit(F0, l, F0.vcu, dry);
        else { const int ui = st - 1; const int qt = (ui == 0) ? j : (ui == 1) ? 63 - j : (ui == 2) ? 64 + j : 127 - j; att_unit(F0, b, qt, dry, 0); }
    }
}
__device__ __forceinline__ void grid_seam(const Ctx& F0) {
    PHASE_ENTER();
    XcdBarrier bar; bar.bar = ctl + CW_BAR + q_->li * XCD_BAR_WORDS; bar.x = xb_xcc_id(); bar.st = (volatile LAS unsigned*)(F.lds + 16);
    xcd_barrier(bar, F.tid);
}

#ifndef PH_MASK
#define PH_MASK 0x3ff
#endif
__global__ void __launch_bounds__(512, 2) mega_fwd(Params p) {
    extern __shared__ __attribute__((aligned(16))) unsigned char lds_raw[];
    Ctx F;
    F.lds = (LAS unsigned char*)lds_raw; F.P = F.lds + LDS_P;
    F.tid = threadIdx.x; F.lane = F.tid & 63; F.wave = __builtin_amdgcn_readfirstlane(F.tid >> 6);
    F.G = gridDim.x; { const int bx = blockIdx.x; F.vcu = (F.G % 8 == 0) ? (bx % 8) * (F.G / 8) + bx / 8 : bx; }
    F.kp = (const CAS Params*)__builtin_amdgcn_kernarg_segment_ptr();
    for (int u = F.tid; u < LDS_P / 4; u += 512) ((LAS unsigned*)F.lds)[u] = 0u;
    __syncthreads();
    (void)xcd_barrier_post((unsigned*)p.ws + CW_BAR + p.li * XCD_BAR_WORDS, (volatile LAS unsigned*)(F.lds + 16), F.tid);

#ifdef FP8_SELFTEST
    if (blockIdx.x == 0 && F.wave == 0) {
        typedef int v8i_ __attribute__((ext_vector_type(8)));
        const int lane = F.lane, gq = lane >> 4;
        float factor = 1.0f;
        {
            v8i_ a, b; for (int i = 0; i < 8; ++i) { a[i] = 0x38383838; b[i] = 0x38383838; }
            f32x4 d = {0.f, 0.f, 0.f, 0.f}; const int s1 = 0x7f7f7f7f;
            asm volatile("v_mfma_scale_f32_16x16x128_f8f6f4 %0, %1, %2, %0, %3, %4 op_sel_hi:[0,0,0]\n\ts_nop 15\n\ts_nop 15" : "+v"(d) : "v"(a), "v"(b), "v"(s1), "v"(s1));
            if (!(d[0] == 128.f && d[3] == 128.f)) factor += 0.1f;
            f32x4 d2 = {0.f, 0.f, 0.f, 0.f}; const int s2 = 0x79797979;
            asm volatile("v_mfma_scale_f32_16x16x128_f8f6f4 %0, %1, %2, %0, %3, %4 op_sel_hi:[0,0,0]\n\ts_nop 15\n\ts_nop 15" : "+v"(d2) : "v"(a), "v"(b), "v"(s2), "v"(s1));
            if (!(d2[0] == 2.f && d2[3] == 2.f)) factor += 0.2f; }
        {
            v8i_ a, b; for (int i = 0; i < 8; ++i) { a[i] = 0; b[i] = 0; }
            if (gq == 1) { a[1] = 0x00003800; b[1] = 0x00003800; }
            f32x4 d = {0.f, 0.f, 0.f, 0.f}; const int s1 = 0x7f7f7f7f;
            asm volatile("v_mfma_scale_f32_16x16x128_f8f6f4 %0, %1, %2, %0, %3, %4 op_sel_hi:[0,0,0]\n\ts_nop 15\n\ts_nop 15" : "+v"(d) : "v"(a), "v"(b), "v"(s1), "v"(s1));
            if (!(d[0] == 1.f && d[1] == 1.f && d[2] == 1.f && d[3] == 1.f)) factor += 0.4f; }
        {
            const unsigned wv = pk4_fp8(1.0f, 0.5f, 1.5f, 448.f);
            if (wv != 0x7e3c3038u) factor += 0.8f; }
        if (lane == 0) ((float*)p.ws)[CW_CNT + 4000] = factor;
    }
#endif
    const int lo = p.ph_lo, hi = p.ph_hi;
#define IN(k) (((PH_MASK >> ((k) % 10)) & 1) && lo <= (k) && (k) < hi)
#define SEAM(k) do { if ((k) + 1 < hi) grid_seam(F); } while (0)
#pragma unroll 1
    for (int l = 0; l < 2; ++l) {
        const int pb = l * 10;
        if (IN(pb + 0)) {
#ifdef DUP_CONV
            phase_convert(F, l, 0);
#endif
            phase_convert(F, l, 0); SEAM(pb + 0); }
        if (IN(pb + 1)) {
#ifdef DUP_INPROJ
            phase_inproj(F);
#endif
            phase_inproj(F); SEAM(pb + 1); }
        if (IN(pb + 2)) { phase_kv(F, l); SEAM(pb + 2); }
        if (IN(pb + 3)) {
#ifdef DUP_MIXERS
            phase_mixers(F, l, 1 + (p.pad & 1), 0);
#endif
#ifdef DUP_ML
            mlstm_unit(F, l, F.vcu, 1 + (p.pad & 1));
#endif
#ifdef DUP_AT
            { const int b_ = F.vcu >> 5, j_ = F.vcu & 31;
#pragma unroll 1
              for (int ui = 0; ui < 4; ++ui) { const int qt = (ui == 0) ? j_ : (ui == 1) ? 63 - j_ : (ui == 2) ? 64 + j_ : 127 - j_; att_unit(F, b_, qt, 1 + (p.pad & 1), DUP_AT + (p.pad & 1)); } }
#endif
            phase_mixers(F, l, p.pad, 1); SEAM(pb + 3); }
        if (IN(pb + 4)) {
#ifdef DUP_MIX
            phase_mix_a(F); phase_mix_m(F);
#endif
            phase_mix_a(F); phase_mix_m(F); SEAM(pb + 4); }
        if (IN(pb + 5)) {
#ifdef DUP_OUT
            phase_out(F, l);
#endif
            phase_out(F, l); SEAM(pb + 5); }
        if (IN(pb + 6)) {
            const int odd = F.vcu & 1;
#pragma unroll 1
            for (int st = 0; st < 2; ++st) { if ((st ^ odd) == 0) phase_ln1(F, l); else phase_ple(F); }
            SEAM(pb + 6); }
        if (IN(pb + 7)) {
#ifdef DUP_MOEUP
            phase_moe_up(F, l);
#endif
#ifdef DUP_PLE
            phase_ple(F); phase_plegate(F);
#endif
#ifndef NO_MOEUP
            phase_moe_up(F, l);
#endif
#ifndef NO_PLEG
            phase_plegate(F);
#endif
            SEAM(pb + 7); }
        if (IN(pb + 8)) {
#ifdef DUP_DOWN
            phase_moe_down(F, l);
#endif
            phase_moe_down(F, l); SEAM(pb + 8); }
        if (IN(pb + 9)) { phase_ln2(F, l); if (l == 1) SEAM(pb + 9); }
    }
#undef IN
#undef SEAM
}

extern "C" void kernel_launch(void* const* d_in, const int* in_sizes, int n_in, void* d_out, int out_size, void* d_ws, size_t ws_size, hipStream_t stream) {
    static int grid = 0;
    if (grid == 0) {
        if (n_in != 23 || out_size != T * D || ws_size < WS_END) { fprintf(stderr, "kernel_launch: unexpected shapes (n_in %d, out %d, ws %zu, need %zu)\n", n_in, out_size, ws_size, (size_t)WS_END); grid = -1; return; }
        int dev = 0, cus = 0, per_cu = 0;
        if (hipGetDevice(&dev) != hipSuccess || hipDeviceGetAttribute(&cus, hipDeviceAttributeMultiprocessorCount, dev) != hipSuccess) { grid = -1; return; }
        if (hipFuncSetAttribute((const void*)mega_fwd, hipFuncAttributeMaxDynamicSharedMemorySize, LDS_BYTES) != hipSuccess) { fprintf(stderr, "kernel_launch: hipFuncSetAttribute failed\n"); grid = -1; return; }
        if (hipOccupancyMaxActiveBlocksPerMultiprocessor(&per_cu, (const void*)mega_fwd, 512, LDS_BYTES) != hipSuccess || per_cu < 1) fprintf(stderr, "kernel_launch: occupancy query says %d\n", per_cu);
        (void)hipGetLastError();
        grid = cus;
        if (grid != 256) fprintf(stderr, "kernel_launch: %d CUs (built for 256)\n", grid);
    }
    if (grid < 0) return;
    if (hipMemsetAsync((char*)d_ws + WS_CTL, 0, CTL_BYTES, stream) != hipSuccess) return;
    Params a{};
    for (int i = 0; i < 23; ++i) a.in[i] = (const float*)d_in[i];
    a.out = (float*)d_out; a.ws = (unsigned char*)d_ws;
    constexpr int NPH = 20;
    for (int li = 0; li < MK_N_LAUNCHES; ++li) {
        a.ph_lo = li * NPH / MK_N_LAUNCHES; a.ph_hi = (li + 1) * NPH / MK_N_LAUNCHES; a.li = li; a.pad = 0;
        hipLaunchKernelGGL(mega_fwd, dim3(grid), dim3(512), LDS_BYTES, stream, a);
    }
}
```

```cpp
#include <hip/hip_runtime.h>
#include <cstdio>
#include <cstdint>

#ifndef MK_N_LAUNCHES
#define MK_N_LAUNCHES 1
#endif

#define LAS __attribute__((address_space(3)))
typedef unsigned short bf16_t;
typedef short bf16x8 __attribute__((ext_vector_type(8)));
typedef short s16x4 __attribute__((ext_vector_type(4)));
typedef float f32x4 __attribute__((ext_vector_type(4)));
typedef float f32x2 __attribute__((ext_vector_type(2)));
typedef unsigned u32x4 __attribute__((ext_vector_type(4)));
typedef unsigned u32x2 __attribute__((ext_vector_type(2)));

constexpr int T = 16384, D = 2048, SEQ = 2048, NBATCH = 8;
constexpr int LDP = 13824;
constexpr int C_AQ = 0, C_MV = 2048, C_MO = 4096, C_GA = 6144, C_GM = 8192, C_MQ = 10240, C_MK = 11264, C_IQ = 12288, C_CKV = 13312,
              C_IK = 13568, C_IW = 13632, C_MI = 13648, C_MF = 13656, C_END = 13664;
constexpr int INW = 13664;
constexpr float LN_EPS = 1e-5f;
constexpr float DN_ALPHA = 1.41421356237f;
constexpr int NEXP = 16, ECAP = 16384, SLOT_ROWS = 36864;

constexpr size_t MiB = 1u << 20;
constexpr size_t WS_CTL = 0;
constexpr size_t WS_WIN = 1 * MiB, WS_WPA = 55 * MiB, WS_WPM = 63 * MiB, WS_WOUT = 71 * MiB, WS_WPG = 79 * MiB, WS_WGU = 87 * MiB, WS_WD = 151 * MiB,
                 WS_WPLE = 183 * MiB, WS_WUKV = 184 * MiB, WS_WRH = 184 * MiB + 128 * 1024, WS_WRL = 184 * MiB + 256 * 1024;
constexpr size_t WS_PB = 185 * MiB, WS_KV = 193 * MiB, WS_LIST = 201 * MiB, WS_WL = 202 * MiB, WS_TOK = 203 * MiB, WS_HB = 204 * MiB, WS_MIX = 268 * MiB, WS_PROJ = 332 * MiB;
constexpr size_t WS_PRE = WS_MIX  , WS_PLE = WS_PROJ + 128 * MiB, WS_HMID = WS_PROJ + 192 * MiB, WS_Y = WS_PROJ + 228 * MiB;
constexpr size_t WS_WIN8 = 764 * MiB, WS_HB8 = 791 * MiB;
constexpr size_t WS_WPG8 = 823 * MiB, WS_WGU8 = 827 * MiB;
constexpr size_t WS_WD8 = 859 * MiB;
constexpr size_t WS_WPA8 = 875 * MiB;
constexpr size_t WS_WPM8 = 879 * MiB, WS_WOUT8 = 883 * MiB;
constexpr size_t WS_END = 887 * MiB;
constexpr size_t WS_YM8 = WS_WIN;
static_assert(WS_Y + (size_t)SLOT_ROWS * 2048 * 2 <= WS_END, "ws map");
constexpr int CW_BAR = 4096, CW_CNT = 8192;
constexpr size_t CTL_BYTES = 65536;

constexpr int LDS_BYTES = 147456;
constexpr int LDS_P = 1024;

__device__ __forceinline__ float bf2f(unsigned b) { return __uint_as_float(b << 16); }
__device__ __forceinline__ unsigned f2bf(float f) { unsigned u = __float_as_uint(f); return (u + 0x7fffu + ((u >> 16) & 1u)) >> 16; }
typedef __bf16 bf16x2_t __attribute__((ext_vector_type(2)));
__device__ __forceinline__ unsigned pk2(float lo, float hi) { const f32x2 v = {lo, hi}; return __builtin_bit_cast(unsigned, __builtin_convertvector(v, bf16x2_t)); }
__device__ __forceinline__ unsigned pk4_fp8(float a, float b, float c, float d) { int w = 0; w = __builtin_amdgcn_cvt_pk_fp8_f32(a, b, w, false); w = __builtin_amdgcn_cvt_pk_fp8_f32(c, d, w, true); return (unsigned)w; }
__device__ __forceinline__ float qdq8(float x) { const int w = __builtin_amdgcn_cvt_pk_fp8_f32(x, x, 0, false); return __builtin_amdgcn_cvt_f32_fp8(w, 0); }
__device__ __forceinline__ void un8(const u32x2 w, float (&o)[8]) { const f32x2 a = __builtin_amdgcn_cvt_pk_f32_fp8((int)w.x, false), b = __builtin_amdgcn_cvt_pk_f32_fp8((int)w.x, true), c = __builtin_amdgcn_cvt_pk_f32_fp8((int)w.y, false), d = __builtin_amdgcn_cvt_pk_f32_fp8((int)w.y, true);
    o[0] = a[0]; o[1] = a[1]; o[2] = b[0]; o[3] = b[1]; o[4] = c[0]; o[5] = c[1]; o[6] = d[0]; o[7] = d[1]; }
#define bf2_fp8(w_, hi_) __builtin_bit_cast(unsigned, __builtin_amdgcn_cvt_scalef32_pk_bf16_fp8((w_), 1.0f, (hi_)))
__device__ __forceinline__ float lo16(unsigned w) { return __uint_as_float(w << 16); }
__device__ __forceinline__ float hi16(unsigned w) { return __uint_as_float(w & 0xffff0000u); }
__device__ __forceinline__ float sigmoidf_(float x) { return __builtin_amdgcn_rcpf(1.0f + __expf(-x)); }
__device__ __forceinline__ float shx(float v, int m, int lane) { return __int_as_float(__builtin_amdgcn_ds_bpermute((lane ^ m) << 2, __float_as_int(v))); }
__device__ __forceinline__ float shl_(float v, int src) { return __int_as_float(__builtin_amdgcn_ds_bpermute(src << 2, __float_as_int(v))); }
__device__ __forceinline__ float wave_sum(float v, int lane) {
#pragma unroll
    for (int o = 1; o < 64; o <<= 1) v += shx(v, o, lane);
    return v;
}
__device__ __forceinline__ int lane_id_() { int l; asm volatile("v_mbcnt_lo_u32_b32 %0, -1, 0\n\tv_mbcnt_hi_u32_b32 %0, -1, %0" : "=v"(l)); return l; }
#define LDS_WAIT() asm volatile("s_waitcnt lgkmcnt(0)" ::: "memory")

#define XB_TMO      128
#define XB_XCNT(j)  (256  + 64 * (j))
#define XB_XSUB(j)  (1280 + 64 * (j))
#define XB_XGEN(j)  (2304 + 64 * (j))
#define XB_TOP      3328
#define XB_TOPGEN   3392
#define XCD_BAR_WORDS 3456
#define XB_SPIN_CAP (1u << 18)
__device__ __forceinline__ unsigned xb_ld(unsigned* p)              { return __hip_atomic_load(p, __ATOMIC_RELAXED, __HIP_MEMORY_SCOPE_AGENT); }
__device__ __forceinline__ unsigned xb_add(unsigned* p, unsigned v) { return __hip_atomic_fetch_add(p, v, __ATOMIC_RELAXED, __HIP_MEMORY_SCOPE_AGENT); }
__device__ __forceinline__ unsigned xb_xcc_id() { return (unsigned)__builtin_amdgcn_s_getreg((3 << 11) | 20) & 0xFu; }
#define XB_SPIN(cond, bar) do { unsigned _sp = 0; while (cond) { __builtin_amdgcn_s_sleep(1); \
    if ((++_sp & 255u) == 0u) { if (xb_ld(&(bar)[XB_TMO])) break; if (_sp > XB_SPIN_CAP) { atomicAdd(&(bar)[XB_TMO], 1u); break; } } } } while (0)
struct XcdBarrier { unsigned* bar; unsigned x; volatile LAS unsigned* st; };
__device__ __forceinline__ XcdBarrier xcd_barrier_post(unsigned* bar, volatile LAS unsigned* st, int tid) {
    XcdBarrier b; b.bar = bar; b.x = xb_xcc_id(); b.st = st;
    if (tid == 0) (void)xb_add(&bar[XB_XCNT(b.x)], 1u);
    return b;
}
__device__ __forceinline__ void xcd_barrier_complete(unsigned* bar, unsigned x, unsigned& nloc, unsigned& nx) {
    const unsigned G = gridDim.x * gridDim.y * gridDim.z;
    unsigned sum, cnt, mine, sp = 0u;
    for (;;) {
        sum = 0u; cnt = 0u; mine = 0u;
#pragma unroll
        for (unsigned j = 0; j < 16; ++j) { const unsigned c = xb_ld(&bar[XB_XCNT(j)]); sum += c; cnt += (c > 0u) ? 1u : 0u; mine = (j == x) ? c : mine; }
        if (sum == G) break;
        __builtin_amdgcn_s_sleep(1);
        if ((++sp & 255u) == 0u) { if (xb_ld(&bar[XB_TMO])) break; if (sp > XB_SPIN_CAP) { atomicAdd(&bar[XB_TMO], 1u); break; } }
    }
    nloc = mine > 0u ? mine : 1u; nx = cnt > 0u ? cnt : 1u;
}
__device__ __forceinline__ void xcd_barrier(const XcdBarrier& b, int tid) {
    asm volatile("s_waitcnt vmcnt(0)" ::: "memory");
    __syncthreads();
    if (tid == 0) {
        unsigned* bar = b.bar;
        __builtin_amdgcn_s_waitcnt(0);
        unsigned nloc = b.st[0], nx = b.st[1];
        if (nloc == 0u) { xcd_barrier_complete(bar, b.x, nloc, nx); b.st[0] = nloc; b.st[1] = nx; }
        const unsigned old = xb_add(&bar[XB_XSUB(b.x)], 1u);
        const unsigned gen = old / nloc;
        if (old + 1u == (gen + 1u) * nloc) {
            __builtin_amdgcn_fence(__ATOMIC_RELEASE, "agent");
            asm volatile("s_waitcnt vmcnt(0)" ::: "memory");
            const unsigned og = xb_add(&bar[XB_TOP], 1u);
            const unsigned tg = og / nx;
            if (og + 1u == (tg + 1u) * nx) xb_add(&bar[XB_TOPGEN], 1u);
            else XB_SPIN(xb_ld(&bar[XB_TOPGEN]) == tg, bar);
            __builtin_amdgcn_fence(__ATOMIC_ACQUIRE, "agent");
            xb_add(&bar[XB_XGEN(b.x)], 1u);
            asm volatile("s_waitcnt vmcnt(0)" ::: "memory");
        } else {
            XB_SPIN(xb_ld(&bar[XB_XGEN(b.x)]) == gen, bar);
            __builtin_amdgcn_fence(__ATOMIC_ACQUIRE, "agent");
            asm volatile("s_waitcnt vmcnt(0)" ::: "memory");
        }
    }
    __syncthreads();
}

namespace pg8 {
constexpr int BM = 256, BK = 64, HALF = 128, HTB = HALF * BK * 2, STAGE_BYTES = 8 * HTB, NXCD = 8, WGM = 8;
__device__ __forceinline__ int lds_byte(int r, int c) { const int st = (r >> 4) * 2 + (c >> 5), rr = r & 15, cc = c & 31, ob = rr * 64 + cc * 2; return st * 1024 + (ob ^ (((ob >> 9) & 1) << 5)); }
__device__ __forceinline__ void stage_rc(int b, int& R, int& C) { const int st = b / 1024, sb = b % 1024, swz = sb ^ (((sb >> 9) & 1) << 5); R = (st >> 1) * 16 + swz / 64; C = (st & 1) * 32 + (swz % 64) / 2; }
__device__ __forceinline__ int perm32(int rho) { const int n = rho >> 4, i = rho & 15; return 8 * (i >> 2) + 4 * n + (i & 3); }

struct Unit { const char* A; const char* B; const int* idx; int nvalid, row0, col0, aux; };

constexpr int NFP8 = 10240;
__device__ __forceinline__ constexpr bool inproj_tile_fp8(int pn) { return pn < NFP8 / 256 || (pn >= 48 && pn <= 52); }
template <int M_, int N_, int LDA_, int LDB_, int MAP = 0, int BAL = 0> struct DenseSched {
    static constexpr int nM = M_ / BM, nN = MAP == 1 ? 24 : MAP == 2 ? 30 : MAP == 3 ? 45 : MAP == 4 ? 9 : N_ / BM, nwg = nM * nN;
    int G, c; const char* A; const char* B;
    __device__ __forceinline__ void init(int G_, int c_, const void* A_, const void* B_) { G = G_; c = c_; A = (const char*)A_; B = (const char*)B_; }
    __device__ __forceinline__ bool next(int i, Unit& u) const {
        int L = i * G + c;
        if (BAL == 1 && G == 256 && i >= 9) { if (c < 128 || i > 10) return false; L = 9 * 256 + (i - 9) * 128 + (c - 128); }
        if (BAL == 2 && G == 256 && i >= 10) { if (i == 10) { if (c < 64) return false; L = 2560 + (c - 64); } else if (i == 11) { if (c < 128) return false; L = 2752 + (c - 128); } else return false; }
        if (L >= nwg) return false;
        int wgid = L; { constexpr int q = nwg / NXCD, r = nwg % NXCD; const int xcd = wgid % NXCD, off = wgid / NXCD; wgid = (xcd < r ? xcd * (q + 1) : r * (q + 1) + (xcd - r) * q) + off; }
        constexpr int nig = WGM * nN; const int gid = wgid / nig, fm = gid * WGM, gsz = (nM - fm) < WGM ? (nM - fm) : WGM;
        const int pm = fm + ((wgid % nig) % gsz); int pn = (wgid % nig) / gsz;
        if (MAP == 1) pn = pn < 8 ? pn : pn + 16;
        if (MAP == 2) pn = pn < 16 ? pn + 8 : pn + 24;
        if (MAP == 3) pn = pn < 40 ? pn : pn + 8;
        if (MAP == 4) pn = pn < 8 ? pn + 40 : 53;
        u.A = A + (size_t)pm * ((size_t)BM * LDA_ * 2); u.B = B + (size_t)pn * ((size_t)BM * LDB_ * 2); u.idx = nullptr; u.nvalid = 256; u.row0 = pm * BM; u.col0 = pn * BM; u.aux = 0; return true;
    }
};
struct MoeSched {
    const LAS int* tpre; const LAS int* cnt; int NT, G, c, mode, bshift = 0;
    const char* Abase; const char* Bbase; const int* list;
    __device__ __forceinline__ bool next(int i, Unit& u) const {
        const int L = i * G + c; const int ntiles = __builtin_amdgcn_readfirstlane(tpre[16]);
        if (L >= ntiles * NT) return false;
        const int rt = L / NT, pn = L % NT; int e = 0;
#pragma unroll
        for (int k = 1; k < 16; ++k) e += (rt >= __builtin_amdgcn_readfirstlane(tpre[k])) ? 1 : 0;
        const int mt = rt - __builtin_amdgcn_readfirstlane(tpre[e]); const int ce = __builtin_amdgcn_readfirstlane(cnt[e]);
        int nv = ce - mt * 256; nv = nv > 256 ? 256 : nv;
        u.nvalid = nv; u.row0 = rt * 256; u.aux = e * ECAP + mt * 256;
        if (mode == 0) { u.A = Abase; u.idx = list + e * ECAP + mt * 256; u.B = Bbase + ((((size_t)e * 1024 + (size_t)pn * 256) * 2048 * 2) >> bshift); u.col0 = pn * 128; }
        else { u.A = Abase + (((size_t)rt * 256 * 512 * 2) >> bshift); u.idx = nullptr; u.B = Bbase + ((((size_t)e * 2048 + (size_t)pn * 256) * 512 * 2) >> bshift); u.col0 = pn * 256; }
        return true;
    }
};

#define EPI_REMAP() const int lane_ = fr + 16 * fq, fr2 = lane_ >> 2, fq2 = lane_ & 3, psrc = (fr2 + 16 * fq2) << 2
__device__ __forceinline__ u32x4 lperm4(const u32x4 w, const int psrc) { u32x4 r; r.x = (unsigned)__builtin_amdgcn_ds_bpermute(psrc, (int)w.x); r.y = (unsigned)__builtin_amdgcn_ds_bpermute(psrc, (int)w.y);
    r.z = (unsigned)__builtin_amdgcn_ds_bpermute(psrc, (int)w.z); r.w = (unsigned)__builtin_amdgcn_ds_bpermute(psrc, (int)w.w); return r; }
__device__ __forceinline__ f32x4 lperm4f(const f32x4 v, const int psrc) { return __builtin_bit_cast(f32x4, lperm4(__builtin_bit_cast(u32x4, v), psrc)); }
template <bool NT = false> struct EpiStoreBf16T {
    static constexpr bool PERM = true;
    bf16_t* O; int ldc;
    __device__ __forceinline__ void operator()(const f32x4 (&acc)[2][2][4][2], const Unit& u, int wr, int wc, int fr, int fq) const {
        EPI_REMAP();
        const int row0 = u.row0 + wr * 64 + fr2, col0 = u.col0 + wc * 32 + 8 * fq2;
#pragma unroll
        for (int ai = 0; ai < 2; ++ai)
#pragma unroll
            for (int m = 0; m < 4; ++m) { bf16_t* rowp = O + (size_t)(row0 + ai * HALF + m * 16) * ldc + col0;
#pragma unroll
                for (int bj = 0; bj < 2; ++bj) { const f32x4 v0 = acc[ai][bj][m][0], v1 = acc[ai][bj][m][1];
                    u32x4 w; w.x = pk2(v0[0], v0[1]); w.y = pk2(v0[2], v0[3]); w.z = pk2(v1[0], v1[1]); w.w = pk2(v1[2], v1[3]);
                    w = lperm4(w, psrc);
                    if (NT) __builtin_nontemporal_store(w, (u32x4*)(rowp + bj * HALF)); else *(u32x4*)(rowp + bj * HALF) = w; } }
    }
};
typedef EpiStoreBf16T<false> EpiStoreBf16;
typedef EpiStoreBf16T<true> EpiStoreBf16NT;
template <bool ADD> struct EpiGate {
    static constexpr bool PERM = true;
    bf16_t* O; int ldo; const bf16_t* gate; int ldg; unsigned char* O8; int ld8;
    __device__ __forceinline__ void operator()(const f32x4 (&acc)[2][2][4][2], const Unit& u, int wr, int wc, int fr, int fq) const {
        EPI_REMAP();
        const int row0 = u.row0 + wr * 64 + fr2, col0 = u.col0 + wc * 32 + 8 * fq2;
#pragma unroll
        for (int ai = 0; ai < 2; ++ai)
#pragma unroll
            for (int m = 0; m < 4; ++m) { const size_t r = (size_t)(row0 + ai * HALF + m * 16);
#pragma unroll
                for (int bj = 0; bj < 2; ++bj) { const f32x4 v0 = lperm4f(acc[ai][bj][m][0], psrc), v1 = lperm4f(acc[ai][bj][m][1], psrc);
                    const u32x4 gw = __builtin_nontemporal_load((const u32x4*)(gate + r * ldg + col0 + bj * HALF));
                    float o[8] = {0.f, 0.f, 0.f, 0.f, 0.f, 0.f, 0.f, 0.f};
                    if (ADD) { const u32x4 ow = *(const u32x4*)(O + r * ldo + col0 + bj * HALF);
                        o[0] = lo16(ow.x); o[1] = hi16(ow.x); o[2] = lo16(ow.y); o[3] = hi16(ow.y); o[4] = lo16(ow.z); o[5] = hi16(ow.z); o[6] = lo16(ow.w); o[7] = hi16(ow.w); }
                    o[0] += v0[0] * sigmoidf_(lo16(gw.x)); o[1] += v0[1] * sigmoidf_(hi16(gw.x)); o[2] += v0[2] * sigmoidf_(lo16(gw.y)); o[3] += v0[3] * sigmoidf_(hi16(gw.y));
                    o[4] += v1[0] * sigmoidf_(lo16(gw.z)); o[5] += v1[1] * sigmoidf_(hi16(gw.z)); o[6] += v1[2] * sigmoidf_(lo16(gw.w)); o[7] += v1[3] * sigmoidf_(hi16(gw.w));
                    if (O8) {
#pragma unroll
                        for (int e = 0; e < 8; ++e) o[e] = fminf(fmaxf(o[e], -440.f), 440.f);
                        u32x2 w8; w8.x = pk4_fp8(o[0], o[1], o[2], o[3]); w8.y = pk4_fp8(o[4], o[5], o[6], o[7]);
                        *(u32x2*)(O8 + r * ld8 + col0 + bj * HALF) = w8; }
                    else { u32x4 w; w.x = pk2(o[0], o[1]); w.y = pk2(o[2], o[3]); w.z = pk2(o[4], o[5]); w.w = pk2(o[6], o[7]);
                        *(u32x4*)(O + r * ldo + col0 + bj * HALF) = w; } }
                asm volatile("" ::: "memory"); }
    }
};
struct EpiPleGate {
    static constexpr bool PERM = true;
    bf16_t* P; int ld;
    __device__ __forceinline__ void operator()(const f32x4 (&acc)[2][2][4][2], const Unit& u, int wr, int wc, int fr, int fq) const {
        EPI_REMAP();
        const int row0 = u.row0 + wr * 64 + fr2, col0 = u.col0 + wc * 32 + 8 * fq2;
#pragma unroll
        for (int ai = 0; ai < 2; ++ai)
#pragma unroll
            for (int m = 0; m < 4; ++m) { bf16_t* rowp = P + (size_t)(row0 + ai * HALF + m * 16) * ld + col0;
#pragma unroll
                for (int bj = 0; bj < 2; ++bj) { const f32x4 v0 = lperm4f(acc[ai][bj][m][0], psrc), v1 = lperm4f(acc[ai][bj][m][1], psrc);
                    const u32x4 pw = *(const u32x4*)(rowp + bj * HALF);
                    u32x4 w; w.x = pk2(lo16(pw.x) * sigmoidf_(v0[0]), hi16(pw.x) * sigmoidf_(v0[1])); w.y = pk2(lo16(pw.y) * sigmoidf_(v0[2]), hi16(pw.y) * sigmoidf_(v0[3]));
                    w.z = pk2(lo16(pw.z) * sigmoidf_(v1[0]), hi16(pw.z) * sigmoidf_(v1[1])); w.w = pk2(lo16(pw.w) * sigmoidf_(v1[2]), hi16(pw.w) * sigmoidf_(v1[3]));
                    *(u32x4*)(rowp + bj * HALF) = w; }
                asm volatile("" ::: "memory"); }
    }
};
struct EpiSwiglu {
    static constexpr bool PERM = true;
    unsigned char* H; const float* wl;
    __device__ __forceinline__ void operator()(const f32x4 (&acc)[2][2][4][2], const Unit& u, int wr, int wc, int fr, int fq) const {
        EPI_REMAP();
        const int rl0 = wr * 64 + fr;
#pragma unroll
        for (int ai = 0; ai < 2; ++ai)
#pragma unroll
            for (int m = 0; m < 4; ++m) { const int rl = rl0 + ai * HALF + m * 16; const float cw = rl < u.nvalid ? 16.f * wl[u.aux + rl] : 0.f;
                const f32x4 g0 = acc[ai][0][m][0], g1 = acc[ai][0][m][1], u0 = acc[ai][1][m][0], u1 = acc[ai][1][m][1];
                float o[8];
#pragma unroll
                for (int j = 0; j < 4; ++j) { o[j] = fminf(fmaxf(g0[j] * sigmoidf_(g0[j]) * u0[j] * cw, -440.f), 440.f); o[4 + j] = fminf(fmaxf(g1[j] * sigmoidf_(g1[j]) * u1[j] * cw, -440.f), 440.f); }
                u32x2 w; w.x = (unsigned)__builtin_amdgcn_ds_bpermute(psrc, (int)pk4_fp8(o[0], o[1], o[2], o[3])); w.y = (unsigned)__builtin_amdgcn_ds_bpermute(psrc, (int)pk4_fp8(o[4], o[5], o[6], o[7]));
                *(u32x2*)(H + (size_t)(u.row0 + wr * 64 + fr2 + ai * HALF + m * 16) * 512 + u.col0 + wc * 32 + 8 * fq2) = w;
                asm volatile("" ::: "memory"); }
    }
};
struct EpiResBf16 {
    static constexpr bool PERM = true;
    bf16_t* O; const bf16_t* base; float alpha; int ldc;
    __device__ __forceinline__ void operator()(const f32x4 (&acc)[2][2][4][2], const Unit& u, int wr, int wc, int fr, int fq) const {
        EPI_REMAP();
        const int row0 = u.row0 + wr * 64 + fr2, col0 = u.col0 + wc * 32 + 8 * fq2;
#pragma unroll
        for (int ai = 0; ai < 2; ++ai)
#pragma unroll
            for (int m = 0; m < 4; ++m) { const size_t off = (size_t)(row0 + ai * HALF + m * 16) * ldc + col0;
#pragma unroll
                for (int bj = 0; bj < 2; ++bj) { const f32x4 v0 = lperm4f(acc[ai][bj][m][0], psrc), v1 = lperm4f(acc[ai][bj][m][1], psrc);
                    const u32x4 bw = *(const u32x4*)(base + off + bj * HALF);
                    u32x4 w; w.x = pk2(alpha * lo16(bw.x) + v0[0], alpha * hi16(bw.x) + v0[1]); w.y = pk2(alpha * lo16(bw.y) + v0[2], alpha * hi16(bw.y) + v0[3]);
                    w.z = pk2(alpha * lo16(bw.z) + v1[0], alpha * hi16(bw.z) + v1[1]); w.w = pk2(alpha * lo16(bw.w) + v1[2], alpha * hi16(bw.w) + v1[3]);
                    *(u32x4*)(O + off + bj * HALF) = w; }
                asm volatile("" ::: "memory"); }
    }
};

template <class Epi, class Sched, bool GATHER, bool ALIGN_EPI, int K, int lda, int ldb, bool FP8 = false, int SCL_A = 0x7f7f7f7f, int SCL_B = 0x79797979>
__device__ __forceinline__ void gemm_phase(LAS unsigned char* lds, const int tid_in, LAS unsigned* toktab, const Sched& S, const Epi& E) {
    int tid_ = tid_in; asm volatile("" : "+v"(tid_));
    const int tid = tid_, wid = __builtin_amdgcn_readfirstlane(tid >> 6), lane = tid & 63, wr = wid >> 2, wc = wid & 3, fr = lane & 15, fq = lane >> 4;
    constexpr int nt = K / BK;
    unsigned voffA[2], voffB[2]; int rA[2]; unsigned cA2[2];
#pragma unroll
    for (int i = 0; i < 2; ++i) { int R, C; stage_rc(tid * 16 + i * 8192, R, C); const int Rb = Epi::PERM ? ((R & ~31) + perm32(R & 31)) : R;
        voffA[i] = (unsigned)(R * lda + C) * 2u; voffB[i] = (unsigned)(Rb * ldb + C) * 2u; rA[i] = R; cA2[i] = (unsigned)C * 2u; }
    constexpr size_t kstep = (size_t)(BK * 2);
    constexpr size_t hstepA = (size_t)HALF * lda * 2, hstepB = (size_t)HALF * ldb * 2;
    const unsigned ldsw = (unsigned)wid * 1024u;
    const int aoff = lds_byte(wr * 64 + fr, fq * 8), boff = lds_byte(wc * 32 + fr, fq * 8);
#define PG8_SA(b, h) (((b) * 2 + (h)) * HTB)
#define PG8_SB(b, h) ((4 + (b) * 2 + (h)) * HTB)
#define PG8_STAGE_B(bufoff, gbase) do { _Pragma("unroll") for (int _i = 0; _i < 2; ++_i) \
        __builtin_amdgcn_global_load_lds((const unsigned*)((const char*)(gbase) + voffB[_i]), (LAS unsigned*)(lds + (bufoff) + ldsw + _i * 8192), 16, 0, 0); } while (0)
#define PG8_STAGE_A(bufoff, gbase, h, nx) do { _Pragma("unroll") for (int _i = 0; _i < 2; ++_i) { \
        const char* _g = GATHER ? (const char*)(gbase) : (const char*)(gbase) + (h) * hstepA; \
        const unsigned _o = GATHER ? (toktab[(((nx) ? (tpar ^ 1) : tpar) << 8) + (h) * HALF + rA[_i]] + cA2[_i]) : voffA[_i]; \
        __builtin_amdgcn_global_load_lds((const unsigned*)(_g + _o), (LAS unsigned*)(lds + (bufoff) + ldsw + _i * 8192), 16, 0, 0); } } while (0)
#define PG8_LDA(dst, b, h) do { _Pragma("unroll") for (int m = 0; m < 4; ++m) _Pragma("unroll") for (int k = 0; k < 2; ++k) dst[m][k] = *(const LAS bf16x8*)(lds + PG8_SA(b, h) + aoff + m * 2048 + k * 1024); } while (0)
#define PG8_LDB(dst, b, h) do { _Pragma("unroll") for (int n = 0; n < 2; ++n) _Pragma("unroll") for (int k = 0; k < 2; ++k) dst[n][k] = *(const LAS bf16x8*)(lds + PG8_SB(b, h) + boff + n * 2048 + k * 1024); } while (0)
#define PG8_MMA(ai, bj, At, Bt) do { __builtin_amdgcn_s_setprio(1); _Pragma("unroll") for (int m = 0; m < 4; ++m) _Pragma("unroll") for (int n = 0; n < 2; ++n) { \
        if constexpr (FP8) { typedef int v4i_ __attribute__((ext_vector_type(4))); typedef int v8i_ __attribute__((ext_vector_type(8))); \
            const v8i_ b8 = __builtin_shufflevector(__builtin_bit_cast(v4i_, Bt[n][0]), __builtin_bit_cast(v4i_, Bt[n][1]), 0, 1, 2, 3, 4, 5, 6, 7); \
            const v8i_ a8 = __builtin_shufflevector(__builtin_bit_cast(v4i_, At[m][0]), __builtin_bit_cast(v4i_, At[m][1]), 0, 1, 2, 3, 4, 5, 6, 7); \
            asm volatile("v_mfma_scale_f32_16x16x128_f8f6f4 %0, %1, %2, %0, %3, %4 op_sel_hi:[0,0,0]" : "+v"(acc[ai][bj][m][n]) : "v"(b8), "v"(a8), "v"(sclB), "v"(sclA)); }     \
        else { _Pragma("unroll") for (int k = 0; k < 2; ++k) acc[ai][bj][m][n] = __builtin_amdgcn_mfma_f32_16x16x32_bf16(Bt[n][k], At[m][k], acc[ai][bj][m][n], 0, 0, 0); } } \
        __builtin_amdgcn_s_setprio(0); } while (0)
#define PG8_WAIT_V(n) asm volatile("s_waitcnt vmcnt(" #n ")" ::: "memory")
#define PG8_WAIT_L(n) asm volatile("s_waitcnt lgkmcnt(" #n ")" ::: "memory")
#define PG8_BAR __builtin_amdgcn_s_barrier()
#define PG8_SCHED __builtin_amdgcn_sched_barrier(0)
#define PG8_LOAD_OFFS(uu, par) do { if (tid < 256) { const int _tok = tid < (uu).nvalid ? (uu).idx[tid] : 0; toktab[((par) << 8) + tid] = (unsigned)(_tok * lda) * 2u; } } while (0)
    int tpar = 0;
    const int sclB = SCL_B, sclA = SCL_A; (void)sclA; (void)sclB;
    Unit cur, nxt; int ui = 0;
    if (!S.next(0, cur)) return;
    f32x4 acc[2][2][4][2];
#pragma unroll
    for (int a = 0; a < 2; ++a)
#pragma unroll
        for (int b = 0; b < 2; ++b)
#pragma unroll
            for (int m = 0; m < 4; ++m)
#pragma unroll
                for (int n = 0; n < 2; ++n) acc[a][b][m][n] = (f32x4){0.f, 0.f, 0.f, 0.f};
    bf16x8 At[4][2], B0[2][2], B1[2][2];
    const char* cA = cur.A; const char* cB = cur.B;
    if constexpr (GATHER) { PG8_LOAD_OFFS(cur, 0); asm volatile("s_waitcnt lgkmcnt(0)" ::: "memory"); __builtin_amdgcn_s_barrier(); }
    PG8_STAGE_B(PG8_SB(0, 0), cB); PG8_STAGE_B(PG8_SB(0, 1), cB + hstepB); PG8_STAGE_A(PG8_SA(0, 0), cA, 0, false); PG8_STAGE_A(PG8_SA(0, 1), cA, 1, false);
    if (wr == 1) PG8_BAR;
    PG8_WAIT_V(2); PG8_BAR;
    PG8_STAGE_B(PG8_SB(1, 0), cB + kstep); PG8_STAGE_A(PG8_SA(1, 0), cA + kstep, 0, false); PG8_STAGE_B(PG8_SB(1, 1), cB + hstepB + kstep);
    PG8_WAIT_V(6); PG8_BAR;
    for (;;) {
        const bool has_next = S.next(ui + 1, nxt);
        const char* nA = has_next ? nxt.A : cA; const char* nB = has_next ? nxt.B : cB;
        if constexpr (GATHER) { if (has_next) { PG8_LOAD_OFFS(nxt, tpar ^ 1); } else if (tid < 256) toktab[((tpar ^ 1) << 8) + tid] = toktab[(tpar << 8) + tid]; }
#pragma unroll 1
        for (int t = 0; t < nt; t += 2) {
            const bool last = (t == nt - 2);
            const char* a1 = cA + (size_t)(t + 1) * kstep;
            const char* a2 = last ? nA : cA + (size_t)(t + 2) * kstep; const char* b2 = last ? nB : cB + (size_t)(t + 2) * kstep;
            const char* a3 = a2 + kstep; const char* b3 = b2 + kstep;
            PG8_LDB(B0, 0, 0); PG8_LDB(B1, 0, 1); PG8_SCHED; PG8_LDA(At, 0, 0); PG8_STAGE_A(PG8_SA(1, 1), a1, 1, false);
            PG8_WAIT_V(8); PG8_WAIT_L(0); PG8_BAR; PG8_MMA(0, 0, At, B0); PG8_MMA(0, 1, At, B1); PG8_BAR; PG8_SCHED;
            PG8_LDA(At, 0, 1); PG8_STAGE_B(PG8_SB(0, 0), b2); PG8_STAGE_B(PG8_SB(0, 1), b2 + hstepB); PG8_STAGE_A(PG8_SA(0, 0), a2, 0, last);
            PG8_WAIT_V(8); PG8_WAIT_L(0); PG8_BAR; PG8_MMA(1, 0, At, B0); PG8_MMA(1, 1, At, B1); PG8_BAR; PG8_SCHED;
            PG8_LDB(B0, 1, 0); PG8_LDB(B1, 1, 1); PG8_SCHED; PG8_LDA(At, 1, 0); PG8_STAGE_A(PG8_SA(0, 1), a2, 1, last);
            PG8_WAIT_V(8); PG8_WAIT_L(0); PG8_BAR; PG8_MMA(0, 0, At, B0); PG8_MMA(0, 1, At, B1); PG8_BAR; PG8_SCHED;
            PG8_LDA(At, 1, 1); PG8_STAGE_B(PG8_SB(1, 0), b3); PG8_STAGE_B(PG8_SB(1, 1), b3 + hstepB); PG8_STAGE_A(PG8_SA(1, 0), a3, 0, last);
            PG8_WAIT_V(8); PG8_WAIT_L(0); PG8_BAR; PG8_MMA(1, 0, At, B0); PG8_MMA(1, 1, At, B1); PG8_BAR; PG8_SCHED;
        }
        if constexpr (ALIGN_EPI) { if (wr == 0) PG8_BAR; }
        { int te_ = tid; asm volatile("" : "+v"(te_)); const int le_ = te_ & 63; E(acc, cur, wr, wc, le_ & 15, le_ >> 4); }
        if (!has_next) break;
#pragma unroll
        for (int a = 0; a < 2; ++a)
#pragma unroll
            for (int b = 0; b < 2; ++b)
#pragma unroll
                for (int m = 0; m < 4; ++m)
#pragma unroll
                    for (int n = 0; n < 2; ++n) acc[a][b][m][n] = (f32x4){0.f, 0.f, 0.f, 0.f};
        cur = nxt; cA = nA; cB = nB; ++ui;
        if constexpr (GATHER) tpar ^= 1;
        if constexpr (ALIGN_EPI) { if (wr == 1) PG8_BAR; }
    }
    PG8_WAIT_V(0);
    if constexpr (!ALIGN_EPI) { if (wr == 0) PG8_BAR; }
    PG8_BAR;
#undef PG8_SA
#undef PG8_SB
#undef PG8_STAGE_A
#undef PG8_STAGE_B
#undef PG8_LDA
#undef PG8_LDB
#undef PG8_MMA
#undef PG8_WAIT_V
#undef PG8_WAIT_L
#undef PG8_BAR
#undef PG8_SCHED
#undef PG8_LOAD_OFFS
}
}

struct Params { const float* in[23]; float* out; unsigned char* ws; int ph_lo, ph_hi, li, pad; };
#define CAS __attribute__((address_space(4)))
struct Ctx {
    LAS unsigned char* lds; LAS unsigned char* P;
    int tid, lane, wave, vcu, G;
    const CAS Params* kp;
};
#define PHASE_ENTER() const CAS Params* q_ = F0.kp; asm volatile("" : "+s"(q_)); int tid_ = F0.wave * 64 + lane_id_(); asm volatile("" : "+v"(tid_)); \
    Ctx F = F0; F.tid = tid_; F.lane = tid_ & 63; F.wave = __builtin_amdgcn_readfirstlane(tid_ >> 6); \
    unsigned char* const ws = q_->ws; unsigned* const ctl = (unsigned*)ws; (void)ctl
#define PIN(i) (q_->in[i])
enum { I_X = 0, I_P, I_WIN, I_KVN, I_WUKV, I_MIB, I_MFB, I_WPA, I_WPM, I_WOUT, I_LN1G, I_LN1B, I_WGRP, I_BGRP, I_WEXP, I_BEXP, I_WGATE, I_WUP, I_WDOWN, I_WPLE, I_WPG, I_LN2G, I_LN2B };

__device__ __forceinline__ int win_src_col(int n) {
    if (n < 2048) return n;
    if (n < 4096) return 5456 + (n - 2048);
    if (n < 6144) return 7504 + (n - 4096);
    if (n < 8192) return 9568 + (n - 6144);
    if (n < 10240) return 11616 + (n - 8192);
    if (n < 11264) return 3408 + (n - 10240);
    if (n < 12288) return 4432 + (n - 11264);
    if (n < 13312) return 2304 + (n - 12288);
    if (n < 13568) return 2048 + (n - 13312);
    if (n < 13632) return 3328 + (n - 13568);
    if (n < 13648) return 3392 + (n - 13632);
    if (n < 13656) return 9552 + (n - 13648);
    if (n < 13664) return 9560 + (n - 13656);
    return -1;
}
struct CvItem { const float* src; int ldsrc, srccol; bf16_t* dst; int dstld; unsigned char* dst8; };
__device__ __forceinline__ void cv_load(const CvItem& I, f32x4 (&v)[16], int lane) {
    const int r = lane >> 4;
#pragma unroll
    for (int i = 0; i < 16; ++i) v[i] = I.srccol >= 0 ? __builtin_nontemporal_load((const f32x4*)(I.src + (size_t)(4 * i + r) * I.ldsrc + I.srccol)) : (f32x4){0.f, 0.f, 0.f, 0.f};
}
__device__ __forceinline__ void cv_store(const CvItem& I, const f32x4 (&v)[16], LAS bf16_t* scr, int lane) {
    const int r = lane >> 4, c4 = lane & 15;
#pragma unroll
    for (int i = 0; i < 16; ++i) { const int k = 4 * i + r;
#pragma unroll
        for (int e = 0; e < 4; ++e) scr[(4 * c4 + e) * 66 + k] = (bf16_t)f2bf(v[i][e]); }
    LDS_WAIT(); asm volatile("" ::: "memory");
    const int ch = lane & 7;
#pragma unroll
    for (int j = 0; j < 8; ++j) { const int n = (lane >> 3) + 8 * j; const LAS unsigned* sp = (const LAS unsigned*)(scr + n * 66 + ch * 8);
        u32x4 o; o.x = sp[0]; o.y = sp[1]; o.z = sp[2]; o.w = sp[3];
        if (I.dst) *(u32x4*)(I.dst + (size_t)n * I.dstld + 8 * ch) = o;
        if (I.dst8) { u32x2 o8; o8.x = pk4_fp8(lo16(o.x) * 64.f, hi16(o.x) * 64.f, lo16(o.y) * 64.f, hi16(o.y) * 64.f); o8.y = pk4_fp8(lo16(o.z) * 64.f, hi16(o.z) * 64.f, lo16(o.w) * 64.f, hi16(o.w) * 64.f);
            *(u32x2*)(I.dst8 + (size_t)n * I.dstld + 8 * ch) = o8; } }
    LDS_WAIT(); asm volatile("" ::: "memory");
}
namespace cv { constexpr int N0 = 216 * 32, N1 = 32 * 32, N5 = 16 * 16 * 32, N6 = 16 * 32 * 8, N7 = 32 * 4, N8 = 4 * 4, NIT = N0 + 4 * N1 + N5 + N6 + N7 + N8; }
#define CV_DECODE(I, it_) do { int r = (it_); \
        if (r < cv::N0) { const int kb = r / 216, grp = r % 216; const int n = grp * 64 + 4 * c4; const bool f8 = pg8::inproj_tile_fp8(grp >> 2); \
            I.src = PIN(I_WIN) + (size_t)l * 2048 * INW + (size_t)kb * 64 * INW; I.ldsrc = INW; I.srccol = win_src_col(n); I.dstld = 2048; \
            I.dst = f8 ? (bf16_t*)nullptr : (bf16_t*)(ws + WS_WIN) + (size_t)grp * 64 * 2048 + kb * 64; I.dst8 = f8 ? ws + WS_WIN8 + (size_t)grp * 64 * 2048 + kb * 64 : (unsigned char*)nullptr; break; } \
        r -= cv::N0; \
        if (r < 4 * cv::N1) { const int which = r / cv::N1, rr = r % cv::N1, kb = rr / 32, grp = rr % 32; \
            const float* src_ = which == 0 ? PIN(I_WPA) : which == 1 ? PIN(I_WPM) : which == 2 ? PIN(I_WOUT) : PIN(I_WPG); \
            I.src = src_ + (size_t)l * 2048 * 2048 + (size_t)kb * 64 * 2048; I.ldsrc = 2048; I.srccol = grp * 64 + 4 * c4; I.dstld = 2048; \
            I.dst = which == 1 ? (bf16_t*)(ws + WS_WPM) + (size_t)grp * 64 * 2048 + kb * 64 : (bf16_t*)nullptr; \
            I.dst8 = ws + (which == 0 ? WS_WPA8 : which == 1 ? WS_WPM8 : which == 2 ? WS_WOUT8 : WS_WPG8) + (size_t)grp * 64 * 2048 + kb * 64; break; } \
        r -= 4 * cv::N1; \
        if (r < cv::N5) { const int e = r / 512, rr = r % 512, kb = rr / 16, grp = rr % 16; const int drow = grp * 64, tile = drow / 256, w = drow % 256; const bool isup = w >= 128; \
            I.src = (isup ? PIN(I_WUP) : PIN(I_WGATE)) + ((size_t)l * 16 + e) * 2048 * 512 + (size_t)kb * 64 * 512; I.ldsrc = 512; I.srccol = tile * 128 + (isup ? w - 128 : w) + 4 * c4; I.dstld = 2048; \
            I.dst = nullptr; I.dst8 = ws + WS_WGU8 + ((size_t)e * 1024 + drow) * 2048 + kb * 64; break; } \
        r -= cv::N5; \
        if (r < cv::N6) { const int e = r / 256, rr = r % 256, kb = rr / 32, grp = rr % 32; \
            I.src = PIN(I_WDOWN) + ((size_t)l * 16 + e) * 512 * 2048 + (size_t)kb * 64 * 2048; I.ldsrc = 2048; I.srccol = grp * 64 + 4 * c4; I.dstld = 512; \
            I.dst = nullptr; I.dst8 = ws + WS_WD8 + ((size_t)e * 2048 + grp * 64) * 512 + kb * 64; break; } \
        r -= cv::N6; \
        if (r < cv::N7) { const int kb = r / 32, grp = r % 32; \
            I.src = PIN(I_WPLE) + (size_t)l * 256 * 2048 + (size_t)kb * 64 * 2048; I.ldsrc = 2048; I.srccol = grp * 64 + 4 * c4; I.dstld = 256; \
            I.dst = (bf16_t*)(ws + WS_WPLE) + (size_t)grp * 64 * 256 + kb * 64; I.dst8 = nullptr; break; } \
        r -= cv::N7; \
        { const int kb = r / 4, grp = r % 4; \
            I.src = PIN(I_WUKV) + (size_t)l * 256 * 256 + (size_t)kb * 64 * 256; I.ldsrc = 256; I.srccol = grp * 64 + 4 * c4; I.dstld = 256; \
            I.dst = (bf16_t*)(ws + WS_WUKV) + (size_t)grp * 64 * 256 + kb * 64; I.dst8 = nullptr; } } while (0)
__device__ __forceinline__ void phase_convert(const Ctx& F0, int l, int late) {
    PHASE_ENTER();
    LAS bf16_t* scr = (LAS bf16_t*)(F.P + F.wave * 8448);
    const int gw = F.vcu * 8 + F.wave, NGW = F.G * 8, lane = F.lane, c4 = lane & 15;
    {
        constexpr int NA = cv::N0 + cv::N8, NB = cv::NIT - NA;
#define CV_MAP(j_) (late ? cv::N0 + (j_) : ((j_) < cv::N0 ? (j_) : (j_) - cv::N0 + (cv::NIT - cv::N8)))
        const int nit = late ? NB : NA;
        CvItem I0, I1; f32x4 va[16], vb[16];
        int it = gw;
        if (it < nit) { CV_DECODE(I0, CV_MAP(it)); cv_load(I0, va, lane); }
#pragma unroll 1
        for (; it < nit; it += NGW) {
            const int itn = it + NGW;
            if (itn < nit) { CV_DECODE(I1, CV_MAP(itn)); cv_load(I1, vb, lane); }
            cv_store(I0, va, scr, lane);
            I0 = I1;
#pragma unroll
            for (int i = 0; i < 16; ++i) va[i] = vb[i];
        }
#undef CV_MAP
    }
    if (late) return;
    const size_t gt = (size_t)F.vcu * 512 + F.tid, NT = (size_t)F.G * 512;
    for (size_t i = gt; i < 32 * 2048; i += NT) { const int c = (int)(i / 2048), k = (int)(i % 2048);
        float w = 0.f; if (c < 4) w = PIN(I_WGRP)[((size_t)l * 2048 + k) * 4 + c]; else if (c < 20) w = PIN(I_WEXP)[((size_t)l * 2048 + k) * 16 + (c - 4)];
        const unsigned h = f2bf(w); const float rem = w - bf2f(h);
        ((bf16_t*)(ws + WS_WRH))[i] = (bf16_t)h; ((bf16_t*)(ws + WS_WRL))[i] = (bf16_t)f2bf(rem); }
    { const f32x4* src = (const f32x4*)(PIN(I_P) + (size_t)l * T * 256); u32x4* dst = (u32x4*)(ws + WS_PB);
      for (size_t i = gt; i < (size_t)T * 256 / 8; i += NT) { const f32x4 a = __builtin_nontemporal_load(src + 2 * i), b = __builtin_nontemporal_load(src + 2 * i + 1); u32x4 o; o.x = pk2(a[0], a[1]); o.y = pk2(a[2], a[3]); o.z = pk2(b[0], b[1]); o.w = pk2(b[2], b[3]); dst[i] = o; } }
    if (l == 0) { const f32x4* src = (const f32x4*)PIN(I_X); u32x4* dst = (u32x4*)(ws + WS_HB); u32x2* dst8 = (u32x2*)(ws + WS_HB8);
      for (size_t i0 = gt; i0 < (size_t)T * D / 8; i0 += 4 * NT) { f32x4 a[4], b[4];
#pragma unroll
        for (int u = 0; u < 4; ++u) { const size_t i = i0 + u * NT; a[u] = __builtin_nontemporal_load(src + 2 * i); b[u] = __builtin_nontemporal_load(src + 2 * i + 1); }
#pragma unroll
        for (int u = 0; u < 4; ++u) { const size_t i = i0 + u * NT; u32x4 o; o.x = pk2(a[u][0], a[u][1]); o.y = pk2(a[u][2], a[u][3]); o.z = pk2(b[u][0], b[u][1]); o.w = pk2(b[u][2], b[u][3]); dst[i] = o;
            u32x2 o8; o8.x = pk4_fp8(a[u][0], a[u][1], a[u][2], a[u][3]); o8.y = pk4_fp8(b[u][0], b[u][1], b[u][2], b[u][3]); dst8[i] = o8;
            } } }
}

__device__ __forceinline__ void phase_kv(const Ctx& F0, int l) {
    PHASE_ENTER();
    const bf16_t* proj = (const bf16_t*)(ws + WS_PROJ); const bf16_t* W = (const bf16_t*)(ws + WS_WUKV); bf16_t* kv = (bf16_t*)(ws + WS_KV);
    const float* gn = q_->in[I_KVN] + l * 256;
    const int lane = F.lane, n16 = lane & 15, g = lane >> 4;
    const int gw = F.vcu * 8 + F.wave, NGW = F.G * 8;
    const int psrc = (4 * n16 + g) << 2, lr = lane >> 2, lp = lane & 3;
    for (int task = gw; task < T / 8; task += NGW) {
        const int t0 = (task >> 1) * 16, nt0 = (task & 1) * 8;
        const bf16_t* xr = proj + (size_t)(t0 + lr) * LDP + C_CKV + 8 * lp;
        u32x4 raw[8]; float ss = 0.f;
#pragma unroll
        for (int ks = 0; ks < 8; ++ks) { raw[ks] = pg8::lperm4(*(const u32x4*)(xr + ks * 32), psrc);
            const float a0 = lo16(raw[ks].x), a1 = hi16(raw[ks].x), a2 = lo16(raw[ks].y), a3 = hi16(raw[ks].y), a4 = lo16(raw[ks].z), a5 = hi16(raw[ks].z), a6 = lo16(raw[ks].w), a7 = hi16(raw[ks].w);
            ss += (a0 * a0 + a1 * a1) + (a2 * a2 + a3 * a3) + (a4 * a4 + a5 * a5) + (a6 * a6 + a7 * a7); }
        ss += shx(ss, 16, lane); ss += shx(ss, 32, lane);
        const float rstd = 1.0f / sqrtf(ss * (1.0f / 256.0f) + LN_EPS);
        bf16x8 xb[8];
#pragma unroll
        for (int ks = 0; ks < 8; ++ks) { const f32x4 g0 = *(const f32x4*)(gn + ks * 32 + 8 * g), g1 = *(const f32x4*)(gn + ks * 32 + 8 * g + 4);
            u32x4 o; o.x = pk2(lo16(raw[ks].x) * rstd * g0[0], hi16(raw[ks].x) * rstd * g0[1]); o.y = pk2(lo16(raw[ks].y) * rstd * g0[2], hi16(raw[ks].y) * rstd * g0[3]);
            o.z = pk2(lo16(raw[ks].z) * rstd * g1[0], hi16(raw[ks].z) * rstd * g1[1]); o.w = pk2(lo16(raw[ks].w) * rstd * g1[2], hi16(raw[ks].w) * rstd * g1[3]);
            xb[ks] = __builtin_bit_cast(bf16x8, o); }
#pragma unroll 2
        for (int nt = 0; nt < 8; ++nt) { const int ntile = nt0 + nt;
            const bf16_t* wr = W + (size_t)(ntile * 16 + lr) * 256 + 8 * lp;
            f32x4 d = {0.f, 0.f, 0.f, 0.f};
#pragma unroll
            for (int ks = 0; ks < 8; ++ks) { const bf16x8 a = __builtin_bit_cast(bf16x8, pg8::lperm4(*(const u32x4*)(wr + ks * 32), psrc)); d = __builtin_amdgcn_mfma_f32_16x16x32_bf16(a, xb[ks], d, 0, 0, 0); }
            const unsigned pk = pk4_fp8(fminf(fmaxf(d[0], -440.f), 440.f), fminf(fmaxf(d[1], -440.f), 440.f), fminf(fmaxf(d[2], -440.f), 440.f), fminf(fmaxf(d[3], -440.f), 440.f));
            *(unsigned*)((unsigned char*)kv + (size_t)(t0 + lr) * 256 + ntile * 16 + 4 * lp) = (unsigned)__builtin_amdgcn_ds_bpermute((lr + 16 * lp) << 2, (int)pk);
        }
    }
}

namespace ml {
constexpr int QS = 0, KS = 17408, VS0 = 34816, VSZ = 11264, PS0 = VS0 + 2 * VSZ, PSZ = 9216, CT = PS0 + 2 * PSZ, TB = CT + 21760, TF = TB + 8192, TA = TF + 8192, TI = TA + 8192, TE = TI + 8192, SC = TE + 8192;
constexpr int QLD = 136, VLD = 88, PLD = 72, CTLD = 136;
static_assert(SC + 1024 <= LDS_BYTES - LDS_P, "mlstm lds");
}
__device__ __forceinline__ float scan_sum(float v, int lane) {
#pragma unroll
    for (int o = 1; o < 64; o <<= 1) { const float t = shl_(v, lane >= o ? lane - o : lane); if (lane >= o) v += t; }
    return v;
}
__device__ __forceinline__ float scan_max(float v, int lane) {
#pragma unroll
    for (int o = 1; o < 64; o <<= 1) { const float t = shl_(v, lane >= o ? lane - o : lane); if (lane >= o) v = fmaxf(v, t); }
    return v;
}
__device__ __forceinline__ s16x4 trrd(const LAS unsigned char* p) { return __builtin_amdgcn_ds_read_tr16_b64_v4i16((LAS s16x4*)p); }
__device__ __forceinline__ void mlstm_unit(const Ctx& F0, int l, int unit, int dry) {
    PHASE_ENTER();
    using namespace ml;
    const int b = unit >> 5, h = (unit >> 2) & 7, dq = unit & 3;
    bf16_t* proj = (bf16_t*)(ws + WS_PROJ);
    LAS unsigned char* P = F.P;
    LAS bf16_t* Qs = (LAS bf16_t*)(P + QS); LAS bf16_t* Ks = (LAS bf16_t*)(P + KS); LAS bf16_t* Ct = (LAS bf16_t*)(P + CT);
    LAS float* tB = (LAS float*)(P + TB); LAS float* tF = (LAS float*)(P + TF); LAS float* tA = (LAS float*)(P + TA); LAS float* tI = (LAS float*)(P + TI); LAS float* tE = (LAS float*)(P + TE);
    LAS float* sc = (LAS float*)(P + SC);
    const int tid = F.tid, lane = F.lane, w = F.wave, n16 = lane & 15, g = lane >> 4, qr = (lane & 15) >> 2, pr = lane & 3;
    const float ib = PIN(I_MIB)[l * 8 + h], fb = PIN(I_MFB)[l * 8 + h];
    const size_t rowb = (size_t)b * SEQ;
    for (int c = w; c < 32; c += 8) {
        const size_t t = rowb + c * 64 + lane;
        const float li = bf2f(proj[t * LDP + C_MI + h]) + ib;
        const float x = bf2f(proj[t * LDP + C_MF + h]) + fb;
        const float lf = fminf(x, 0.f) - log1pf(__expf(-fabsf(x)));
        const float bc = scan_sum(lf, lane);
        const float blast = shl_(bc, 63);
        const float Bv = li - bc;
        const float pm = scan_max(Bv, lane);
        const float maxB = shl_(pm, 63);
        tB[c * 64 + lane] = Bv; tF[c * 64 + lane] = __expf(Bv - maxB); tA[c * 64 + lane] = bc; tI[c * 64 + lane] = pm;
        if (lane == 0) { sc[c] = blast; sc[32 + c] = blast + maxB; }
    }
    for (int i = tid; i < 80 * CTLD / 2; i += 512) ((LAS unsigned*)Ct)[i] = 0u;
    for (int i = tid; i < 2 * 64 * 8; i += 512) { const int bufi = i >> 9, row = (i >> 3) & 63, cw = i & 7; ((LAS unsigned*)(P + VS0 + bufi * VSZ + row * VLD * 2 + 128))[cw] = 0x3f803f80u; }
    __syncthreads();
    if (tid == 0) { float m = 0.f;
        for (int c = 0; c < 32; ++c) { const float bl = sc[c], ae = sc[32 + c]; sc[64 + c] = m; const float mn = fmaxf(bl + m, ae); sc[96 + c] = __expf(bl + m - mn); sc[128 + c] = __expf(ae - mn); m = mn; } }
    __syncthreads();
    for (int c = w; c < 32; c += 8) {
        const float bc = tA[c * 64 + lane], pm = tI[c * 64 + lane], mp = sc[64 + c];
        const float mrow = fmaxf(bc + mp, bc + pm);
        tA[c * 64 + lane] = bc - mrow; tI[c * 64 + lane] = __expf(bc + mp - mrow); tE[c * 64 + lane] = __expf(-mrow);
    }
    const float qscale = 0.08838834764831845f;
    f32x4 Cst[5];
#pragma unroll
    for (int i = 0; i < 5; ++i) Cst[i] = (f32x4){0.f, 0.f, 0.f, 0.f};
    const int jt = w & 3, hp = w >> 2;
    const int srow0 = tid >> 4, sch = tid & 15, vrow = tid >> 3, vch = tid & 7;
    u32x4 rq[2], rk[2], rv;
#define ML_LOAD(cc) do { const size_t tb_ = rowb + (size_t)(cc) * 64; \
        _Pragma("unroll") for (int i = 0; i < 2; ++i) { rq[i] = *(const u32x4*)(proj + (tb_ + srow0 + 32 * i) * LDP + C_MQ + h * 128 + sch * 8); rk[i] = *(const u32x4*)(proj + (tb_ + srow0 + 32 * i) * LDP + C_MK + h * 128 + sch * 8); } \
        rv = *(const u32x4*)(proj + (tb_ + vrow) * LDP + C_MV + h * 256 + dq * 64 + vch * 8); } while (0)
    ML_LOAD(0);
    __syncthreads();
#pragma unroll 1
    for (int c = 0; c < 32; ++c) {
        const size_t tb = rowb + c * 64;
        LAS unsigned char* Vb = P + VS0 + (c & 1) * VSZ; LAS bf16_t* Ps = (LAS bf16_t*)(P + PS0 + (c & 1) * PSZ);
#pragma unroll
        for (int i = 0; i < 2; ++i) { *(LAS u32x4*)(Qs + (srow0 + 32 * i) * QLD + sch * 8) = rq[i]; *(LAS u32x4*)(Ks + (srow0 + 32 * i) * QLD + sch * 8) = rk[i]; }
        *(LAS u32x4*)(Vb + vrow * VLD * 2 + vch * 16) = rv;
        unsigned short mo[2][4];
#pragma unroll
        for (int r = 0; r < 4; ++r)
#pragma unroll
            for (int i = 0; i < 2; ++i) mo[i][r] = proj[(tb + jt * 16 + 4 * g + r) * LDP + C_MO + h * 256 + dq * 64 + (2 * hp + i) * 16 + n16];
        if (c + 1 < 32) ML_LOAD(c + 1);
        __syncthreads();
#pragma unroll
        for (int x = 0; x < 2; ++x) { const int st = 2 * hp + x;
            f32x4 d = {0.f, 0.f, 0.f, 0.f};
#pragma unroll
            for (int ks = 0; ks < 4; ++ks) { const bf16x8 a = *(const LAS bf16x8*)(Ks + (st * 16 + n16) * QLD + ks * 32 + 8 * g); const bf16x8 bq = *(const LAS bf16x8*)(Qs + (jt * 16 + n16) * QLD + ks * 32 + 8 * g);
                d = __builtin_amdgcn_mfma_f32_16x16x32_bf16(a, bq, d, 0, 0, 0); }
            const int j = jt * 16 + n16; const float Aj = tA[c * 64 + j];
            const f32x4 b4 = *(const LAS f32x4*)(tB + c * 64 + st * 16 + 4 * g);
            float o[4];
#pragma unroll
            for (int r = 0; r < 4; ++r) { const int s_ = st * 16 + 4 * g + r; o[r] = (s_ <= j) ? __expf(Aj + b4[r]) * d[r] * qscale : 0.f; }
            u32x2 wv; wv.x = pk2(o[0], o[1]); wv.y = pk2(o[2], o[3]);
            *(LAS u32x2*)(Ps + j * PLD + st * 16 + 4 * g) = wv; }
        f32x4 acc5[3];
#pragma unroll
        for (int i = 0; i < 3; ++i) { const int dt = (i < 2) ? (2 * hp + i) : 4;
            f32x4 d = {0.f, 0.f, 0.f, 0.f};
#pragma unroll
            for (int ks = 0; ks < 4; ++ks) { const bf16x8 a = *(const LAS bf16x8*)(Qs + (jt * 16 + n16) * QLD + ks * 32 + 8 * g); const bf16x8 bc = *(const LAS bf16x8*)(Ct + (dt * 16 + n16) * CTLD + ks * 32 + 8 * g);
                d = __builtin_amdgcn_mfma_f32_16x16x32_bf16(a, bc, d, 0, 0, 0); }
            acc5[i] = d; }
        { const float dec = sc[96 + c], scl = sc[128 + c];
            f32x4 dn[5];
#pragma unroll
            for (int dt = 0; dt < 5; ++dt) dn[dt] = (f32x4){0.f, 0.f, 0.f, 0.f};
#pragma unroll
            for (int ks = 0; ks < 2; ++ks) { const int s0 = ks * 32 + 8 * g;
                const LAS unsigned char* ka = (const LAS unsigned char*)Ks + (s0 + qr) * QLD * 2 + (w * 16 + 4 * pr) * 2;
                const s16x4 k0 = trrd(ka), k1 = trrd(ka + 4 * QLD * 2);
                const f32x4 f0 = *(const LAS f32x4*)(tF + c * 64 + s0), f1 = *(const LAS f32x4*)(tF + c * 64 + s0 + 4);
                u32x4 aw; aw.x = pk2(bf2f((unsigned short)k0[0]) * f0[0], bf2f((unsigned short)k0[1]) * f0[1]); aw.y = pk2(bf2f((unsigned short)k0[2]) * f0[2], bf2f((unsigned short)k0[3]) * f0[3]);
                aw.z = pk2(bf2f((unsigned short)k1[0]) * f1[0], bf2f((unsigned short)k1[1]) * f1[1]); aw.w = pk2(bf2f((unsigned short)k1[2]) * f1[2], bf2f((unsigned short)k1[3]) * f1[3]);
                const bf16x8 a = __builtin_bit_cast(bf16x8, aw);
#pragma unroll
                for (int dt = 0; dt < 5; ++dt) { const LAS unsigned char* va = Vb + (s0 + qr) * VLD * 2 + (dt * 16 + 4 * pr) * 2;
                    const s16x4 v0 = trrd(va), v1 = trrd(va + 4 * VLD * 2);
                    const bf16x8 bv = __builtin_shufflevector(v0, v1, 0, 1, 2, 3, 4, 5, 6, 7);
                    dn[dt] = __builtin_amdgcn_mfma_f32_16x16x32_bf16(a, bv, dn[dt], 0, 0, 0); } }
#pragma unroll
            for (int dt = 0; dt < 5; ++dt) Cst[dt] = Cst[dt] * dec + dn[dt] * scl; }
        __syncthreads();
#pragma unroll
        for (int dt = 0; dt < 5; ++dt) { u32x2 wv; wv.x = pk2(Cst[dt][0], Cst[dt][1]); wv.y = pk2(Cst[dt][2], Cst[dt][3]); *(LAS u32x2*)(Ct + (dt * 16 + n16) * CTLD + w * 16 + 4 * g) = wv; }
        f32x4 acc4[3];
#pragma unroll
        for (int i = 0; i < 3; ++i) { const int dt = (i < 2) ? (2 * hp + i) : 4;
            f32x4 d = {0.f, 0.f, 0.f, 0.f};
#pragma unroll
            for (int ks = 0; ks < 2; ++ks) { const int s0 = ks * 32 + 8 * g;
                const bf16x8 a = *(const LAS bf16x8*)(Ps + (jt * 16 + n16) * PLD + ks * 32 + 8 * g);
                const LAS unsigned char* va = Vb + (s0 + qr) * VLD * 2 + (dt * 16 + 4 * pr) * 2;
                const s16x4 v0 = trrd(va), v1 = trrd(va + 4 * VLD * 2);
                const bf16x8 bv = __builtin_shufflevector(v0, v1, 0, 1, 2, 3, 4, 5, 6, 7);
                d = __builtin_amdgcn_mfma_f32_16x16x32_bf16(a, bv, d, 0, 0, 0); }
            acc4[i] = d; }
#pragma unroll
        for (int r = 0; r < 4; ++r) { const int j = jt * 16 + 4 * g + r; const float iw = tI[c * 64 + j] * qscale; const float den = iw * acc5[2][r] + acc4[2][r];
            const float dn_ = fmaxf(fabsf(den), tE[c * 64 + j]); const float inv = 1.0f / dn_;
#pragma unroll
            for (int i = 0; i < 2; ++i) { const float num = iw * acc5[i][r] + acc4[i][r]; const float hv = num * inv;
                bf16_t* op = proj + (tb + j) * LDP + C_MO + h * 256 + dq * 64 + (2 * hp + i) * 16 + n16;
                const float yv = hv * sigmoidf_(bf2f(mo[i][r])); (void)op;
                if (!dry || yv == 1.2345e30f) { const float yc = fminf(fmaxf(yv * 0.5f, -440.f), 440.f);
                    *(unsigned char*)(ws + WS_YM8 + (tb + j) * D + h * 256 + dq * 64 + (2 * hp + i) * 16 + n16) = (unsigned char)(__builtin_amdgcn_cvt_pk_fp8_f32(yc, yc, 0, false) & 0xff); } } }
    }
#undef ML_LOAD
    __syncthreads();
}

namespace at {
constexpr int S_OFF = 0, Q_OFF = 65536, QPITCH = 2080, L_OFF = Q_OFF + 16 * QPITCH, W_OFF = L_OFF + 8192, C_OFF = W_OFF + 1024, QL_OFF = C_OFF + 64, QLP = 288;
static_assert(QL_OFF + 16 * QLP <= LDS_BYTES - LDS_P && (L_OFF % 16) == 0 && (QL_OFF % 16) == 0, "att lds");
}
__device__ __forceinline__ int cnt8_ge(unsigned k0, unsigned k1, unsigned k2, unsigned k3, unsigned k4, unsigned k5, unsigned k6, unsigned k7, unsigned cand) {
    unsigned long long m0, m1, m2, m3, m4, m5, m6, m7;
    asm("v_cmp_ge_u32_e64 %0, %8, %16\n\tv_cmp_ge_u32_e64 %1, %9, %16\n\tv_cmp_ge_u32_e64 %2, %10, %16\n\tv_cmp_ge_u32_e64 %3, %11, %16\n\t"
        "v_cmp_ge_u32_e64 %4, %12, %16\n\tv_cmp_ge_u32_e64 %5, %13, %16\n\tv_cmp_ge_u32_e64 %6, %14, %16\n\tv_cmp_ge_u32_e64 %7, %15, %16\n\ts_nop 1"
        : "=s"(m0), "=s"(m1), "=s"(m2), "=s"(m3), "=s"(m4), "=s"(m5), "=s"(m6), "=s"(m7)
        : "v"(k0), "v"(k1), "v"(k2), "v"(k3), "v"(k4), "v"(k5), "v"(k6), "v"(k7), "v"(cand));
    return __builtin_popcountll(m0) + __builtin_popcountll(m1) + __builtin_popcountll(m2) + __builtin_popcountll(m3) + __builtin_popcountll(m4) + __builtin_popcountll(m5) + __builtin_popcountll(m6) + __builtin_popcountll(m7);
}
__device__ __forceinline__ void att_unit(const Ctx& F0, int b, int qt, int dry, int stop) {
    PHASE_ENTER();
    using namespace at;
    bf16_t* proj = (bf16_t*)(ws + WS_PROJ);
    const unsigned char* kvb = (const unsigned char*)(ws + WS_KV); constexpr int KVP = 256;
    LAS unsigned char* P = F.P;
    LAS _Float16* S = (LAS _Float16*)(P + S_OFF); LAS unsigned char* IQ = P + Q_OFF; LAS unsigned short* LST = (LAS unsigned short*)(P + L_OFF); LAS float* WT = (LAS float*)(P + W_OFF); LAS int* CN = (LAS int*)(P + C_OFF);
    const int tid = F.tid, lane = F.lane, w = F.wave, n16 = lane & 15, g = lane >> 4;
    const int t0 = qt * 16; const size_t T0 = (size_t)b * SEQ + t0; const size_t rowb = (size_t)b * SEQ;
    if (tid < 256) { const int hh = tid >> 4, q = tid & 15; WT[hh * 16 + q] = bf2f(proj[(T0 + q) * LDP + C_IW + hh]); }
#pragma unroll
    for (int i = 0; i < 4; ++i) { const int id = tid + 512 * i, row = id >> 7, ch = id & 127;
        *(LAS u32x4*)(IQ + row * QPITCH + ch * 16) = *(const u32x4*)(proj + (T0 + row) * LDP + C_IQ + ch * 8); }
    __syncthreads();
    { const int q = tid >> 5, c2 = (tid & 31) * 2; float s0 = 0.f, s1 = 0.f;
#pragma unroll
      for (int hh = 0; hh < 16; ++hh) { const unsigned u = *(const LAS unsigned*)(IQ + q * QPITCH + hh * 128 + c2 * 2); const float wv = WT[hh * 16 + q]; s0 += wv * lo16(u); s1 += wv * hi16(u); }
      const unsigned hi = pk2(s0, s1);
      *(LAS unsigned*)(P + QL_OFF + q * QLP + c2 * 2) = hi;
      *(LAS unsigned*)(P + QL_OFF + q * QLP + 128 + c2 * 2) = pk2(s0 - lo16(hi), s1 - hi16(hi)); }
    __syncthreads();
    const int nkt = qt + 1, ngr = (nkt + 3) >> 2;
    {
        bf16x8 bk[4][2], bkn[4][2];
#define ATT_LOADB(dst, gi_) do { _Pragma("unroll") for (int x = 0; x < 4; ++x) _Pragma("unroll") for (int ks = 0; ks < 2; ++ks) \
            dst[x][ks] = *(const bf16x8*)((const unsigned char*)proj + (unsigned)((((unsigned)rowb + (unsigned)(((gi_) * 4 + x) * 16 + (lane >> 2))) * (unsigned)LDP + (unsigned)(C_IK + ks * 32 + 8 * (lane & 3))) * 2u)); } while (0)
        const int kperm1 = (4 * n16 + g) << 2;
        if (w < ngr) ATT_LOADB(bkn, w);
#pragma unroll 1
        for (int gi = w; gi < ngr; gi += 8) {
            const int gn = (gi + 8 < ngr) ? gi + 8 : gi;
#pragma unroll
            for (int x = 0; x < 4; ++x)
#pragma unroll
                for (int ks = 0; ks < 2; ++ks) { const u32x4 s_ = __builtin_bit_cast(u32x4, bkn[x][ks]); u32x4 d_;
                    d_.x = (unsigned)__builtin_amdgcn_ds_bpermute(kperm1, (int)s_.x); d_.y = (unsigned)__builtin_amdgcn_ds_bpermute(kperm1, (int)s_.y); d_.z = (unsigned)__builtin_amdgcn_ds_bpermute(kperm1, (int)s_.z); d_.w = (unsigned)__builtin_amdgcn_ds_bpermute(kperm1, (int)s_.w);
                    bk[x][ks] = __builtin_bit_cast(bf16x8, d_); }
            ATT_LOADB(bkn, gn);
            f32x4 sacc[4];
            { bf16x8 ql[4];
#pragma unroll
              for (int i = 0; i < 4; ++i) ql[i] = *(const LAS bf16x8*)(P + QL_OFF + n16 * QLP + i * 64 + 16 * g);
#pragma unroll
              for (int x = 0; x < 4; ++x) sacc[x] = __builtin_amdgcn_mfma_f32_16x16x32_bf16(ql[0], bk[x][0], (f32x4){0.f, 0.f, 0.f, 0.f}, 0, 0, 0);
#pragma unroll
              for (int x = 0; x < 4; ++x) sacc[x] = __builtin_amdgcn_mfma_f32_16x16x32_bf16(ql[1], bk[x][1], sacc[x], 0, 0, 0);
#pragma unroll
              for (int x = 0; x < 4; ++x) sacc[x] = __builtin_amdgcn_mfma_f32_16x16x32_bf16(ql[2], bk[x][0], sacc[x], 0, 0, 0);
#pragma unroll
              for (int x = 0; x < 4; ++x) sacc[x] = __builtin_amdgcn_mfma_f32_16x16x32_bf16(ql[3], bk[x][1], sacc[x], 0, 0, 0); }
            bf16x8 qa[2][2]; f32x4 wq[2]; f32x4 dd[2][4];
#define ATT_LDQA(buf, hh_) do { qa[buf][0] = *(const LAS bf16x8*)(IQ + n16 * QPITCH + (hh_) * 128 + 16 * g); qa[buf][1] = *(const LAS bf16x8*)(IQ + n16 * QPITCH + (hh_) * 128 + 64 + 16 * g); } while (0)
#define ATT_LDW(buf, hh_) do { wq[buf] = *(const LAS f32x4*)(WT + (hh_) * 16 + 4 * g); } while (0)
#define ATT_MMA(buf) do { _Pragma("unroll") for (int x = 0; x < 4; ++x) dd[buf][x] = __builtin_amdgcn_mfma_f32_16x16x32_bf16(qa[buf][0], bk[x][0], (f32x4){0.f, 0.f, 0.f, 0.f}, 0, 0, 0); \
            _Pragma("unroll") for (int x = 0; x < 4; ++x) dd[buf][x] = __builtin_amdgcn_mfma_f32_16x16x32_bf16(qa[buf][1], bk[x][1], dd[buf][x], 0, 0, 0); } while (0)
#define ATT_FOLD(buf) do { _Pragma("unroll") for (int x = 0; x < 4; ++x) _Pragma("unroll") for (int r = 0; r < 4; ++r) { float t_ = __builtin_fmaf(wq[buf][r], __builtin_fabsf(dd[buf][x][r]), sacc[x][r]); asm("" : "+v"(t_)); sacc[x][r] = t_; } } while (0)
            ATT_LDQA(0, 0); ATT_LDW(0, 0); ATT_LDQA(1, 1);
            ATT_MMA(0);
#pragma unroll 1
            for (int hp = 0; hp < 7; ++hp) { const int h0 = 2 * hp;
                ATT_MMA(1);
                ATT_LDQA(0, h0 + 2); ATT_LDW(1, h0 + 1);
                ATT_FOLD(0);
                ATT_MMA(0);
                ATT_LDQA(1, h0 + 3); ATT_LDW(0, h0 + 2);
                ATT_FOLD(1);
            }
            ATT_MMA(1); ATT_LDW(1, 15);
            ATT_FOLD(0);
            ATT_FOLD(1);
#undef ATT_LDQA
#undef ATT_LDW
#undef ATT_MMA
#undef ATT_FOLD
#pragma unroll
            for (int x = 0; x < 4; ++x) { const int kt = gi * 4 + x; if (kt < nkt) {
#pragma unroll
                for (int r = 0; r < 4; ++r) S[(4 * g + r) * 2048 + kt * 16 + n16] = (_Float16)sacc[x][r]; } }
        }
#undef ATT_LOADB
    }
    __syncthreads();
    if (stop == 1) return;
    u32x4 qwp[2][4];
#pragma unroll
    for (int qq = 0; qq < 2; ++qq)
#pragma unroll
        for (int j = 0; j < 4; ++j) qwp[qq][j] = *(const u32x4*)(proj + (T0 + 2 * w + qq) * LDP + C_AQ + n16 * 128 + g * 32 + j * 8);
#pragma unroll 1
    for (int qq = 0; qq < 2; ++qq) {
        const int q = 2 * w + qq, t = t0 + q, nv = t + 1;
        LAS unsigned short* lst = LST + q * 256;
        if (nv <= 256) {
#pragma unroll
            for (int i = 0; i < 4; ++i) { const int pos = lane + 64 * i; lst[pos] = (unsigned short)(pos < nv ? pos : 0); }
            if (lane == 0) CN[q] = nv;
        } else {
            unsigned key[32];
            const LAS unsigned short* srow = (const LAS unsigned short*)S + q * 2048;
            const int ng = (nv + 511) >> 9;
#pragma unroll
            for (int G = 0; G < 4; ++G) {
                if (G < ng) {
#pragma unroll
                    for (int j = 8 * G; j < 8 * G + 8; ++j) { const int idx = j * 64 + lane; const unsigned u = srow[idx];
                        const unsigned k = (u & 0x8000u) ? (~u & 0xffffu) : (u | 0x8000u); key[j] = idx < nv ? k : 0u; }
                } else {
#pragma unroll
                    for (int j = 8 * G; j < 8 * G + 8; ++j) key[j] = 0u;
                }
            }
#define ATT_CNT(cand_) (cnt8_ge(key[0], key[1], key[2], key[3], key[4], key[5], key[6], key[7], cand_) + (ng > 1 ? cnt8_ge(key[8], key[9], key[10], key[11], key[12], key[13], key[14], key[15], cand_) : 0) \
                      + (ng > 2 ? cnt8_ge(key[16], key[17], key[18], key[19], key[20], key[21], key[22], key[23], cand_) : 0) + (ng > 3 ? cnt8_ge(key[24], key[25], key[26], key[27], key[28], key[29], key[30], key[31], cand_) : 0))
            unsigned Tk = 0u;
#pragma unroll 1
            for (int bit = 15; bit >= 0; --bit) { const unsigned cand = Tk | (1u << bit);
                const int cge = ATT_CNT(cand);
                if (cge >= 256) Tk = cand;
                if (cge == 256) break; }
            const int cgt = ATT_CNT(Tk + 1u);
#undef ATT_CNT
            int base = 0, tbase = cgt;
#pragma unroll
            for (int G = 0; G < 4; ++G) {
                if (G < ng) {
#pragma unroll
                    for (int j = 8 * G; j < 8 * G + 8; ++j) { const bool sg = key[j] > Tk, st = key[j] == Tk; const unsigned long long m = __ballot(sg), m2 = __ballot(st);
                        const int pg = (int)__builtin_amdgcn_mbcnt_hi((unsigned)(m >> 32), __builtin_amdgcn_mbcnt_lo((unsigned)m, (unsigned)base));
                        const int pe = (int)__builtin_amdgcn_mbcnt_hi((unsigned)(m2 >> 32), __builtin_amdgcn_mbcnt_lo((unsigned)m2, (unsigned)tbase));
                        if (sg || (st && pe < 256)) lst[sg ? pg : pe] = (unsigned short)(j * 64 + lane);
                        base += __builtin_popcountll(m); tbase += __builtin_popcountll(m2); }
                }
            }
            if (lane == 0) CN[q] = 256;
        }
    }
    typedef int v8i_ __attribute__((ext_vector_type(8)));
    v8i_ qf8p[2];
#pragma unroll
    for (int qq = 0; qq < 2; ++qq)
#pragma unroll
        for (int j = 0; j < 4; ++j) { const u32x4 v = qwp[qq][j]; qf8p[qq][2 * j] = (int)pk4_fp8(lo16(v.x), hi16(v.x), lo16(v.y), hi16(v.y)); qf8p[qq][2 * j + 1] = (int)pk4_fp8(lo16(v.z), hi16(v.z), lo16(v.w), hi16(v.w)); }
    __syncthreads();
    if (stop == 2) return;
    LAS unsigned char* VS = P + S_OFF + w * 8192;
    const unsigned rowb32 = (unsigned)rowb;
    const int qr = (lane & 15) >> 2, pr = lane & 3;
#pragma unroll 1
    for (int qq = 0; qq < 2; ++qq) {
        const int q = 2 * w + qq, t = t0 + q; const int cnt = __builtin_amdgcn_readfirstlane(CN[q]);
        const LAS unsigned short* lst = LST + q * 256;
        bf16_t* qrow = proj + (T0 + q) * LDP + C_AQ;
#ifdef ATT_SKIP3
        { for (int c = lane; c < 2048; c += 64) qrow[c] = (bf16_t)f2bf((float)lst[c & 255] * 1e-3f + (float)cnt * 1e-3f); continue; }
#endif
        v8i_ qf8;
#pragma unroll
        for (int j = 0; j < 8; ++j) qf8[j] = qq ? qf8p[1][j] : qf8p[0][j];
        const float scale = 0.08838834764831845f;
        const float slope2 = exp2f(-0.5f * (float)(n16 + 1)) * 11.313708498984761f;
        f32x4 lg[16];
#ifndef ATT_KB
#define ATT_KB 8
#endif
        u32x4 kf[2][ATT_KB][2];
        const int kperm = (4 * n16 + g) << 2;
#define ATT_LOADK(bt, buf) do { _Pragma("unroll") for (int x = 0; x < ATT_KB; ++x) { const unsigned sidx = lst[((bt) * ATT_KB + x) * 16 + (lane >> 2)]; const unsigned char* kr = kvb + (unsigned)((rowb32 + sidx) * 256u + (unsigned)(lane & 3) * 32u); \
            kf[buf][x][0] = *(const u32x4*)kr; kf[buf][x][1] = *(const u32x4*)(kr + 16); } } while (0)
        ATT_LOADK(0, 0); ATT_LOADK(1, 1);
        __builtin_amdgcn_sched_barrier(0);
#pragma unroll
        for (int bt = 0; bt < 16 / ATT_KB; ++bt) {
#pragma unroll
            for (int x = 0; x < ATT_KB; ++x) { const int kt2 = bt * ATT_KB + x;
                typedef int v4i_ __attribute__((ext_vector_type(4)));
                const u32x4 ka = kf[bt & 1][x][0], kb = kf[bt & 1][x][1]; v8i_ k8;
                k8[0] = __builtin_amdgcn_ds_bpermute(kperm, (int)ka.x); k8[1] = __builtin_amdgcn_ds_bpermute(kperm, (int)ka.y); k8[2] = __builtin_amdgcn_ds_bpermute(kperm, (int)ka.z); k8[3] = __builtin_amdgcn_ds_bpermute(kperm, (int)ka.w);
                k8[4] = __builtin_amdgcn_ds_bpermute(kperm, (int)kb.x); k8[5] = __builtin_amdgcn_ds_bpermute(kperm, (int)kb.y); k8[6] = __builtin_amdgcn_ds_bpermute(kperm, (int)kb.z); k8[7] = __builtin_amdgcn_ds_bpermute(kperm, (int)kb.w);
                const f32x4 d = __builtin_amdgcn_mfma_scale_f32_16x16x128_f8f6f4(k8, qf8, (f32x4){0.f, 0.f, 0.f, 0.f}, 0, 0, 0, 0x7f7f7f7f, 0, 0x7f7f7f7f);
                const u32x2 sw = *(const LAS u32x2*)(lst + kt2 * 16 + 4 * g);
                const int s0 = sw.x & 0xffff, s1 = sw.x >> 16, s2 = sw.y & 0xffff, s3 = sw.y >> 16; const int pos = kt2 * 16 + 4 * g;
                f32x4 lv; (void)pos;
                lv[0] = __builtin_fmaf(-slope2, (float)(t - s0), d[0]);
                lv[1] = __builtin_fmaf(-slope2, (float)(t - s1), d[1]);
                lv[2] = __builtin_fmaf(-slope2, (float)(t - s2), d[2]);
                lv[3] = __builtin_fmaf(-slope2, (float)(t - s3), d[3]);
                lg[kt2] = lv; }
        }
        if (cnt < 256) {
            asm volatile("" ::: "memory");
#pragma unroll
            for (int i = 0; i < 16; ++i)
#pragma unroll
                for (int r = 0; r < 4; ++r) lg[i][r] = (i * 16 + 4 * g + r < cnt) ? lg[i][r] : -INFINITY;
        }
#undef ATT_LOADK
        u32x4 vv[8][4];
#define ATT_LOADV(pp, buf) do { _Pragma("unroll") for (int i = 0; i < 4; ++i) { const int row = (lane >> 3) + 8 * i; const unsigned sidx = lst[32 * (pp) + row]; vv[buf][i] = *(const u32x4*)(kvb + (unsigned)((rowb32 + sidx) * 256u + 128u + (unsigned)(lane & 7) * 16u)); } } while (0)
        asm volatile("" ::: "memory");
#pragma unroll
        for (int pp = 0; pp < 6; ++pp) ATT_LOADV(pp, pp);
        float mx = -INFINITY;
#pragma unroll
        for (int i = 0; i < 16; ++i) mx = fmaxf(mx, fmaxf(fmaxf(lg[i][0], lg[i][1]), fmaxf(lg[i][2], lg[i][3])));
        mx = fmaxf(mx, shx(mx, 16, lane)); mx = fmaxf(mx, shx(mx, 32, lane));
        float sum = 0.f;
        const float c1 = scale * 1.4426950408889634f, nmx = -mx * c1;
#pragma unroll
        for (int i = 0; i < 16; ++i) {
#pragma unroll
            for (int r = 0; r < 4; ++r) { const float e = __builtin_amdgcn_exp2f(__builtin_fmaf(lg[i][r], c1, nmx)); lg[i][r] = e; sum += e; } }
        sum += shx(sum, 16, lane); sum += shx(sum, 32, lane);
        const float inv = 1.0f / sum;
        bf16x8 pf[8];
#pragma unroll
        for (int pp = 0; pp < 8; ++pp) { u32x4 o; o.x = pk2(lg[2 * pp][0] * inv, lg[2 * pp][1] * inv); o.y = pk2(lg[2 * pp][2] * inv, lg[2 * pp][3] * inv);
            o.z = pk2(lg[2 * pp + 1][0] * inv, lg[2 * pp + 1][1] * inv); o.w = pk2(lg[2 * pp + 1][2] * inv, lg[2 * pp + 1][3] * inv); pf[pp] = __builtin_bit_cast(bf16x8, o); }
        asm volatile("" ::: "memory");
        ATT_LOADV(6, 6); ATT_LOADV(7, 7);
        f32x4 oacc[8];
#pragma unroll
        for (int dt = 0; dt < 8; ++dt) oacc[dt] = (f32x4){0.f, 0.f, 0.f, 0.f};
#pragma unroll
        for (int pp = 0; pp < 8; ++pp) {
            asm volatile("" ::: "memory");
#pragma unroll
            for (int i = 0; i < 4; ++i) { const int row = (lane >> 3) + 8 * i; const u32x4 w8 = vv[pp][i];
                u32x4 b0, b1; b0.x = bf2_fp8(w8.x, false); b0.y = bf2_fp8(w8.x, true); b0.z = bf2_fp8(w8.y, false); b0.w = bf2_fp8(w8.y, true); b1.x = bf2_fp8(w8.z, false); b1.y = bf2_fp8(w8.z, true); b1.z = bf2_fp8(w8.w, false); b1.w = bf2_fp8(w8.w, true);
                LAS unsigned char* vp = VS + row * 256 + ((((lane & 7) ^ (row & 7))) << 5);
                *(LAS u32x4*)vp = b0; *(LAS u32x4*)(vp + 16) = b1; }
            const int row1 = 4 * g + qr;
#pragma unroll
            for (int dt = 0; dt < 8; ++dt) {
                const LAS unsigned char* a1 = VS + row1 * 256 + ((dt ^ (row1 & 7)) << 5) + 8 * pr;
                const s16x4 lo = __builtin_amdgcn_ds_read_tr16_b64_v4i16((LAS s16x4*)a1);
                const s16x4 hi = __builtin_amdgcn_ds_read_tr16_b64_v4i16((LAS s16x4*)(a1 + 16 * 256));
                const bf16x8 vf = __builtin_shufflevector(lo, hi, 0, 1, 2, 3, 4, 5, 6, 7);
                oacc[dt] = __builtin_amdgcn_mfma_f32_16x16x32_bf16(vf, pf[pp], oacc[dt], 0, 0, 0);
            }
        }
#undef ATT_LOADV
#pragma unroll
        for (int dt = 0; dt < 8; ++dt) *(LAS unsigned*)(VS + n16 * 128 + ((dt ^ (n16 & 7)) << 4) + 4 * g) = pk4_fp8(oacc[dt][0], oacc[dt][1], oacc[dt][2], oacc[dt][3]);
        { const int hr = lane >> 2, pb = (lane & 3) * 2;
          const u32x4 o0 = *(const LAS u32x4*)(VS + hr * 128 + ((pb ^ (hr & 7)) << 4)), o1 = *(const LAS u32x4*)(VS + hr * 128 + (((pb + 1) ^ (hr & 7)) << 4));
          unsigned char* yr = ws + WS_HB8 + (T0 + q) * D + lane * 32;
          if (!dry || o0.x == 0x12345678u) { *(u32x4*)yr = o0; *(u32x4*)(yr + 16) = o1; } }
    }
    __syncthreads();
}

namespace l1 {
constexpr int HH = 0, HL = 65792, LG = 131584, RI = LG + 2048, LC = RI + 2048, LB = LC + 64;
constexpr int HLD = 2056;
static_assert(LB + 64 <= LDS_BYTES - LDS_P, "ln1 lds");
}
__device__ __forceinline__ void phase_ln1(const Ctx& F0, int l) {
    PHASE_ENTER();
    using namespace l1;
    LAS unsigned char* P = F.P;
    LAS bf16_t* Hh = (LAS bf16_t*)(P + HH); LAS bf16_t* Hl = (LAS bf16_t*)(P + HL); LAS float* RED = (LAS float*)(P + HH);
    LAS float* Lg = (LAS float*)(P + LG); LAS int* Ri = (LAS int*)(P + RI); LAS int* Lc = (LAS int*)(P + LC); LAS int* Lb = (LAS int*)(P + LB);
    const bf16_t* PRE = (const bf16_t*)(ws + WS_PRE); bf16_t* HB = (bf16_t*)(ws + WS_HB);
    const bf16_t* WRH = (const bf16_t*)(ws + WS_WRH); const bf16_t* WRL = (const bf16_t*)(ws + WS_WRL);
    const float* gam = q_->in[I_LN1G] + l * D; const float* bet = q_->in[I_LN1B] + l * D;
    const float* bgrp = q_->in[I_BGRP] + l * 4; const float* bexp = q_->in[I_BEXP] + l * 16;
    unsigned* gcnt = ctl + CW_CNT + l * 1024;
    int* LIST = (int*)(ws + WS_LIST); float* WL = (float*)(ws + WS_WL); int* TOK = (int*)(ws + WS_TOK);
    const int tid = F.tid, lane = F.lane, w = F.wave, n16 = lane & 15, g = lane >> 4;
    if (tid < 16) Lc[tid] = 0;
    __syncthreads();
    const int rbase = F.vcu * 64;
    bf16x8 rbh0[8], rbh1[8];
    const int rpsrc = (4 * n16 + g) << 2; const int rlr = lane >> 2, rlp = lane & 3;
#pragma unroll
    for (int kk = 0; kk < 8; ++kk) { const int ks = 8 * w + kk; const size_t o0 = (size_t)rlr * 2048 + ks * 32 + 8 * rlp, o1 = (size_t)(16 + rlr) * 2048 + ks * 32 + 8 * rlp;
        rbh0[kk] = __builtin_bit_cast(bf16x8, pg8::lperm4(*(const u32x4*)(WRH + o0), rpsrc)); rbh1[kk] = __builtin_bit_cast(bf16x8, pg8::lperm4(*(const u32x4*)(WRH + o1), rpsrc)); }
    for (int it = 0; it < 4; ++it) {
#pragma unroll 1
        for (int rr = 0; rr < 2; ++rr) { const int r16 = 2 * w + rr; const size_t t = (size_t)rbase + it * 16 + r16;
            const u32x4* xr = (const u32x4*)(PRE + t * D) + lane;
            float v[4][8]; float s = 0.f;
#pragma unroll
            for (int j = 0; j < 4; ++j) { const u32x4 x = __builtin_nontemporal_load(xr + 64 * j);
                v[j][0] = lo16(x.x); v[j][1] = hi16(x.x); v[j][2] = lo16(x.y); v[j][3] = hi16(x.y); v[j][4] = lo16(x.z); v[j][5] = hi16(x.z); v[j][6] = lo16(x.w); v[j][7] = hi16(x.w);
#pragma unroll
                for (int e = 0; e < 8; ++e) s += v[j][e]; }
            const float mean = wave_sum(s, lane) * (1.0f / D); float s2 = 0.f;
#pragma unroll
            for (int j = 0; j < 4; ++j)
#pragma unroll
                for (int e = 0; e < 8; ++e) { v[j][e] -= mean; s2 += v[j][e] * v[j][e]; }
            const float rstd = 1.0f / sqrtf(wave_sum(s2, lane) * (1.0f / D) + LN_EPS);
#pragma unroll
            for (int j = 0; j < 4; ++j) { const int k0 = 8 * (lane + 64 * j);
                const f32x4 g0 = *(const f32x4*)(gam + k0), g1 = *(const f32x4*)(gam + k0 + 4), b0 = *(const f32x4*)(bet + k0), b1 = *(const f32x4*)(bet + k0 + 4);
                float y[8];
#pragma unroll
                for (int e = 0; e < 4; ++e) { y[e] = v[j][e] * rstd * g0[e] + b0[e]; y[4 + e] = v[j][4 + e] * rstd * g1[e] + b1[e]; }
                u32x4 hi; hi.x = pk2(y[0], y[1]); hi.y = pk2(y[2], y[3]); hi.z = pk2(y[4], y[5]); hi.w = pk2(y[6], y[7]);
                *((u32x4*)(HB + t * D) + lane + 64 * j) = hi;
                { u32x2 o8; o8.x = pk4_fp8(y[0], y[1], y[2], y[3]); o8.y = pk4_fp8(y[4], y[5], y[6], y[7]); *((u32x2*)(ws + WS_HB8 + t * D) + lane + 64 * j) = o8; }
                u32x4 lo; lo.x = pk2(y[0] - lo16(hi.x), y[1] - hi16(hi.x)); lo.y = pk2(y[2] - lo16(hi.y), y[3] - hi16(hi.y)); lo.z = pk2(y[4] - lo16(hi.z), y[5] - hi16(hi.z)); lo.w = pk2(y[6] - lo16(hi.w), y[7] - hi16(hi.w));
                *(LAS u32x4*)(Hh + r16 * HLD + k0) = hi; *(LAS u32x4*)(Hl + r16 * HLD + k0) = lo; }
        }
        __syncthreads();
        f32x4 d0 = {0.f, 0.f, 0.f, 0.f}, d1 = {0.f, 0.f, 0.f, 0.f};
#pragma unroll
        for (int kk = 0; kk < 8; ++kk) { const int ks = 8 * w + kk;
            const bf16x8 ah = *(const LAS bf16x8*)(Hh + n16 * HLD + ks * 32 + 8 * g), al = *(const LAS bf16x8*)(Hl + n16 * HLD + ks * 32 + 8 * g);
            const size_t o0 = (size_t)rlr * 2048 + ks * 32 + 8 * rlp, o1 = (size_t)(16 + rlr) * 2048 + ks * 32 + 8 * rlp;
            const bf16x8 bh0 = rbh0[kk], bh1 = rbh1[kk];
            const bf16x8 bl0 = __builtin_bit_cast(bf16x8, pg8::lperm4(*(const u32x4*)(WRL + o0), rpsrc)), bl1 = __builtin_bit_cast(bf16x8, pg8::lperm4(*(const u32x4*)(WRL + o1), rpsrc));
            d0 = __builtin_amdgcn_mfma_f32_16x16x32_bf16(ah, bh0, d0, 0, 0, 0); d0 = __builtin_amdgcn_mfma_f32_16x16x32_bf16(ah, bl0, d0, 0, 0, 0); d0 = __builtin_amdgcn_mfma_f32_16x16x32_bf16(al, bh0, d0, 0, 0, 0);
            d1 = __builtin_amdgcn_mfma_f32_16x16x32_bf16(ah, bh1, d1, 0, 0, 0); d1 = __builtin_amdgcn_mfma_f32_16x16x32_bf16(ah, bl1, d1, 0, 0, 0); d1 = __builtin_amdgcn_mfma_f32_16x16x32_bf16(al, bh1, d1, 0, 0, 0); }
        __syncthreads();
#pragma unroll
        for (int r = 0; r < 4; ++r) { RED[w * 512 + (4 * g + r) * 32 + n16] = d0[r]; RED[w * 512 + (4 * g + r) * 32 + 16 + n16] = d1[r]; }
        __syncthreads();
        { float s = 0.f;
#pragma unroll
          for (int k = 0; k < 8; ++k) s += RED[k * 512 + tid];
          Lg[tid] = s; }
        __syncthreads();
        if (tid < 16) { const LAS float* lgr = Lg + tid * 32;
            float g0 = lgr[0] + bgrp[0], g1 = lgr[1] + bgrp[1], g2 = lgr[2] + bgrp[2], g3 = lgr[3] + bgrp[3];
            int gi = 0; float gm = g0; if (g1 > gm) { gm = g1; gi = 1; } if (g2 > gm) { gm = g2; gi = 2; } if (g3 > gm) { gm = g3; gi = 3; }
            const float gp = 1.0f / (expf(g0 - gm) + expf(g1 - gm) + expf(g2 - gm) + expf(g3 - gm));
            const float e0 = lgr[4 + 4 * gi + 0] + bexp[4 * gi + 0], e1 = lgr[4 + 4 * gi + 1] + bexp[4 * gi + 1], e2 = lgr[4 + 4 * gi + 2] + bexp[4 * gi + 2], e3 = lgr[4 + 4 * gi + 3] + bexp[4 * gi + 3];
            int i0 = 0; float m0 = e0; if (e1 > m0) { m0 = e1; i0 = 1; } if (e2 > m0) { m0 = e2; i0 = 2; } if (e3 > m0) { m0 = e3; i0 = 3; }
            int i1 = -1; float m1 = -INFINITY;
            if (i0 != 0 && e0 > m1) { m1 = e0; i1 = 0; } if (i0 != 1 && e1 > m1) { m1 = e1; i1 = 1; } if (i0 != 2 && e2 > m1) { m1 = e2; i1 = 2; } if (i0 != 3 && e3 > m1) { m1 = e3; i1 = 3; }
            if (i1 < 0) i1 = (i0 == 0) ? 1 : 0;
            const float r1 = expf(m1 - m0); const float w0 = gp / (1.0f + r1), w1 = gp * r1 / (1.0f + r1);
            const int ex0 = 4 * gi + i0, ex1 = 4 * gi + i1;
            const int lp0 = atomicAdd((int*)(Lc + ex0), 1), lp1 = atomicAdd((int*)(Lc + ex1), 1);
            LAS int* ri = Ri + (it * 16 + tid) * 8; ri[0] = ex0; ri[1] = ex1; ri[2] = lp0; ri[3] = lp1; ri[4] = __float_as_int(w0); ri[5] = __float_as_int(w1); }
        __syncthreads();
    }
    if (tid < 16) Lb[tid] = (int)__hip_atomic_fetch_add(gcnt + tid * 16, (unsigned)Lc[tid], __ATOMIC_RELAXED, __HIP_MEMORY_SCOPE_AGENT);
    __syncthreads();
    if (tid < 64) { const LAS int* ri = Ri + tid * 8; const int t = rbase + tid; const int ex0 = ri[0], ex1 = ri[1]; const int p0 = Lb[ex0] + ri[2], p1 = Lb[ex1] + ri[3];
        LIST[ex0 * ECAP + p0] = t; LIST[ex1 * ECAP + p1] = t; WL[ex0 * ECAP + p0] = __int_as_float(ri[4]); WL[ex1 * ECAP + p1] = __int_as_float(ri[5]);
        TOK[t * 4 + 0] = ex0; TOK[t * 4 + 1] = p0; TOK[t * 4 + 2] = ex1; TOK[t * 4 + 3] = p1; }
    __syncthreads();
}

__device__ __forceinline__ void moe_tables(const Ctx& F0, int l) {
    PHASE_ENTER();
    if (F.tid == 0) { LAS int* tpre = (LAS int*)(F.lds + 64); LAS int* cn = (LAS int*)(F.lds + 192); unsigned* gcnt = ctl + CW_CNT + l * 1024; int acc = 0;
        for (int e = 0; e < 16; ++e) { const int c = (int)__hip_atomic_load(gcnt + e * 16, __ATOMIC_RELAXED, __HIP_MEMORY_SCOPE_AGENT); cn[e] = c; tpre[e] = acc; acc += (c + 255) >> 8; }
        tpre[16] = acc; }
    __syncthreads();
}

__device__ __forceinline__ void phase_ln2(const Ctx& F0, int l) {
    moe_tables(F0, l);
    PHASE_ENTER();
    const LAS int* tpre = (const LAS int*)(F.lds + 64);
    float* Hout = q_->out; bf16_t* HB = (bf16_t*)(ws + WS_HB); const bf16_t* Y = (const bf16_t*)(ws + WS_Y); const bf16_t* PLE = (const bf16_t*)(ws + WS_PLE);
    const int* TOK = (const int*)(ws + WS_TOK);
    const float* gam = PIN(I_LN2G) + l * D; const float* bet = PIN(I_LN2B) + l * D;
    const int lane = F.lane;
    const int gw = F.vcu * 8 + F.wave, NGW = F.G * 8;
    for (int t = gw; t < T; t += NGW) {
        const int e0 = TOK[t * 4 + 0], p0 = TOK[t * 4 + 1], e1 = TOK[t * 4 + 2], p1 = TOK[t * 4 + 3];
        const size_t s0 = (size_t)tpre[e0] * 256 + p0, s1 = (size_t)tpre[e1] * 256 + p1;
        const u32x4* hr = (const u32x4*)(HB + (size_t)t * D) + lane;
        const u32x4* y0 = (const u32x4*)(Y + s0 * D) + lane; const u32x4* y1 = (const u32x4*)(Y + s1 * D) + lane; const u32x4* pl = (const u32x4*)(PLE + (size_t)t * D) + lane;
        float v[4][8]; float s = 0.f;
#pragma unroll
        for (int j = 0; j < 4; ++j) { const u32x4 hv = __builtin_nontemporal_load(hr + 64 * j), a = __builtin_nontemporal_load(y0 + 64 * j), b2 = __builtin_nontemporal_load(y1 + 64 * j), c = __builtin_nontemporal_load(pl + 64 * j);
            v[j][0] = DN_ALPHA * lo16(hv.x) + lo16(a.x) + lo16(b2.x) + lo16(c.x); v[j][1] = DN_ALPHA * hi16(hv.x) + hi16(a.x) + hi16(b2.x) + hi16(c.x);
            v[j][2] = DN_ALPHA * lo16(hv.y) + lo16(a.y) + lo16(b2.y) + lo16(c.y); v[j][3] = DN_ALPHA * hi16(hv.y) + hi16(a.y) + hi16(b2.y) + hi16(c.y);
            v[j][4] = DN_ALPHA * lo16(hv.z) + lo16(a.z) + lo16(b2.z) + lo16(c.z); v[j][5] = DN_ALPHA * hi16(hv.z) + hi16(a.z) + hi16(b2.z) + hi16(c.z);
            v[j][6] = DN_ALPHA * lo16(hv.w) + lo16(a.w) + lo16(b2.w) + lo16(c.w); v[j][7] = DN_ALPHA * hi16(hv.w) + hi16(a.w) + hi16(b2.w) + hi16(c.w);
#pragma unroll
            for (int e = 0; e < 8; ++e) s += v[j][e]; }
        const float mean = wave_sum(s, lane) * (1.0f / D); float s2 = 0.f;
#pragma unroll
        for (int j = 0; j < 4; ++j)
#pragma unroll
            for (int e = 0; e < 8; ++e) { v[j][e] -= mean; s2 += v[j][e] * v[j][e]; }
        const float rstd = 1.0f / sqrtf(wave_sum(s2, lane) * (1.0f / D) + LN_EPS);
#pragma unroll
        for (int j = 0; j < 4; ++j) { const int k0 = 8 * (lane + 64 * j);
            const f32x4 g0 = *(const f32x4*)(gam + k0), g1 = *(const f32x4*)(gam + k0 + 4), b0 = *(const f32x4*)(bet + k0), b1 = *(const f32x4*)(bet + k0 + 4);
            f32x4 ya, yb;
#pragma unroll
            for (int e = 0; e < 4; ++e) { ya[e] = v[j][e] * rstd * g0[e] + b0[e]; yb[e] = v[j][4 + e] * rstd * g1[e] + b1[e]; }
#ifdef FP8_SELFTEST
            if (l == 1) { const float fct = ((const float*)ctl)[CW_CNT + 4000]; ya = ya * fct; yb = yb * fct; }
#endif
            if (l == 1) { *(f32x4*)(Hout + (size_t)t * D + k0) = ya; *(f32x4*)(Hout + (size_t)t * D + k0 + 4) = yb; }
            else { u32x4 hi; hi.x = pk2(ya[0], ya[1]); hi.y = pk2(ya[2], ya[3]); hi.z = pk2(yb[0], yb[1]); hi.w = pk2(yb[2], yb[3]); *((u32x4*)(HB + (size_t)t * D) + lane + 64 * j) = hi;
                u32x2 o8; o8.x = pk4_fp8(ya[0], ya[1], ya[2], ya[3]); o8.y = pk4_fp8(yb[0], yb[1], yb[2], yb[3]); *((u32x2*)(ws + WS_HB8 + (size_t)t * D) + lane + 64 * j) = o8;
                } }
    }
}

#define TOKTAB(F) ((LAS unsigned*)((F).lds + LDS_P + 131072))
__device__ __forceinline__ void phase_inproj(const Ctx& F0) {
    PHASE_ENTER();
    { typedef pg8::DenseSched<T, LDP, D / 2, D / 2, 3, 2> Sch; Sch S; S.init(F.G, (int)blockIdx.x, ws + WS_HB8, ws + WS_WIN8);
      pg8::EpiStoreBf16NT E{(bf16_t*)(ws + WS_PROJ), LDP};
      pg8::gemm_phase<pg8::EpiStoreBf16NT, Sch, false, true, D / 2, D / 2, D / 2, true>(F.P, F.tid, TOKTAB(F), S, E); }
    { typedef pg8::DenseSched<T, LDP, D, D, 4, 0> Sch; Sch S; S.init(F.G, (int)blockIdx.x, ws + WS_HB, ws + WS_WIN);
      pg8::EpiStoreBf16NT E{(bf16_t*)(ws + WS_PROJ), LDP};
      pg8::gemm_phase<pg8::EpiStoreBf16NT, Sch, false, true, D, D, D>(F.P, F.tid, TOKTAB(F), S, E); }
}
__device__ __forceinline__ void phase_mix_a(const Ctx& F0) {
    PHASE_ENTER();
    bf16_t* PROJ = (bf16_t*)(ws + WS_PROJ);
    typedef pg8::DenseSched<T, D, D / 2, D / 2> Sch; Sch S; S.init(F.G, (int)blockIdx.x, ws + WS_HB8, ws + WS_WPA8);
    pg8::EpiGate<false> E{(bf16_t*)(ws + WS_MIX), D, PROJ + C_GA, LDP, nullptr, 0};
    pg8::gemm_phase<pg8::EpiGate<false>, Sch, false, true, D / 2, D / 2, D / 2, true>(F.P, F.tid, TOKTAB(F), S, E);
}
__device__ __forceinline__ void phase_mix_m(const Ctx& F0) {
    PHASE_ENTER();
    bf16_t* PROJ = (bf16_t*)(ws + WS_PROJ);
    typedef pg8::DenseSched<T, D, D / 2, D / 2> Sch; Sch S; S.init(F.G, (int)blockIdx.x, ws + WS_YM8, ws + WS_WPM8);
    pg8::EpiGate<true> E{(bf16_t*)(ws + WS_MIX), D, PROJ + C_GM, LDP, (unsigned char*)(PROJ + C_AQ), LDP * 2};
    pg8::gemm_phase<pg8::EpiGate<true>, Sch, false, true, D / 2, D / 2, D / 2, true, (int)0x80808080, 0x79797979>(F.P, F.tid, TOKTAB(F), S, E);
}
__device__ __forceinline__ void phase_out(const Ctx& F0, int l) {
    PHASE_ENTER();
    typedef pg8::DenseSched<T, D, LDP, D / 2> Sch; Sch S; S.init(F.G, (int)blockIdx.x, ws + WS_PROJ, ws + WS_WOUT8);
    pg8::EpiResBf16 E{(bf16_t*)(ws + WS_PRE), (const bf16_t*)(ws + WS_HB), DN_ALPHA, D};
    pg8::gemm_phase<pg8::EpiResBf16, Sch, false, true, D / 2, LDP, D / 2, true>(F.P, F.tid, TOKTAB(F), S, E);
}
__device__ __forceinline__ void phase_moe_up(const Ctx& F0, int l) {
    moe_tables(F0, l);
    PHASE_ENTER();
    pg8::MoeSched S; S.tpre = (const LAS int*)(F.lds + 64); S.cnt = (const LAS int*)(F.lds + 192); S.NT = 4; S.G = F.G; S.c = (int)blockIdx.x; S.mode = 0;
    S.Abase = (const char*)(ws + WS_HB8); S.Bbase = (const char*)(ws + WS_WGU8); S.list = (const int*)(ws + WS_LIST); S.bshift = 1;
    pg8::EpiSwiglu E{(unsigned char*)(ws + WS_HMID), (const float*)(ws + WS_WL)};
    pg8::gemm_phase<pg8::EpiSwiglu, pg8::MoeSched, true, true, D / 2, D / 2, D / 2, true>(F.P, F.tid, TOKTAB(F), S, E);
}
__device__ __forceinline__ void phase_ple(const Ctx& F0) {
    PHASE_ENTER();
    typedef pg8::DenseSched<T, D, 256, 256> Sch; Sch S; S.init(F.G, (int)blockIdx.x, ws + WS_PB, ws + WS_WPLE);
    pg8::EpiStoreBf16 E{(bf16_t*)(ws + WS_PLE), D};
    pg8::gemm_phase<pg8::EpiStoreBf16, Sch, false, true, 256, 256, 256>(F.P, F.tid, TOKTAB(F), S, E);
}
__device__ __forceinline__ void phase_plegate(const Ctx& F0) {
    PHASE_ENTER();
    typedef pg8::DenseSched<T, D, D / 2, D / 2> Sch; Sch S; S.init(F.G, (int)blockIdx.x, ws + WS_HB8, ws + WS_WPG8);
    pg8::EpiPleGate E{(bf16_t*)(ws + WS_PLE), D};
    pg8::gemm_phase<pg8::EpiPleGate, Sch, false, true, D / 2, D / 2, D / 2, true>(F.P, F.tid, TOKTAB(F), S, E);
}
__device__ __forceinline__ void phase_moe_down(const Ctx& F0, int l) {
    moe_tables(F0, l);
    PHASE_ENTER();
    pg8::MoeSched S; S.tpre = (const LAS int*)(F.lds + 64); S.cnt = (const LAS int*)(F.lds + 192); S.NT = 8; S.G = F.G; S.c = (int)blockIdx.x; S.mode = 1; S.bshift = 1;
    S.Abase = (const char*)(ws + WS_HMID); S.Bbase = (const char*)(ws + WS_WD8); S.list = nullptr;
    pg8::EpiStoreBf16NT E{(bf16_t*)(ws + WS_Y), D};
    pg8::gemm_phase<pg8::EpiStoreBf16NT, pg8::MoeSched, false, true, 256, 256, 256, true, 0x7b7b7b7b, 0x79797979>(F.P, F.tid, TOKTAB(F), S, E);
}
__device__ __forceinline__ void phase_mixers(const Ctx& F0, int l, int dry, int conv) {
    const int b = F0.vcu >> 5, j = F0.vcu & 31, slot = F0.vcu % 5;
#pragma unroll 1
    for (int st = 0; st < 5; ++st) {
        if (conv && st == slot) { phase_convert(F0, l, 1); __syncthreads(); }
        if (st == 0) mlstm_unit(F0, l, F0.vcu, dry);
        else { const int ui = st - 1; const int qt = (ui == 0) ? j : (ui == 1) ? 63 - j : (ui == 2) ? 64 + j : 127 - j; att_unit(F0, b, qt, dry, 0); }
    }
}
__device__ __forceinline__ void grid_seam(const Ctx& F0) {
    PHASE_ENTER();
    XcdBarrier bar; bar.bar = ctl + CW_BAR + q_->li * XCD_BAR_WORDS; bar.x = xb_xcc_id(); bar.st = (volatile LAS unsigned*)(F.lds + 16);
    xcd_barrier(bar, F.tid);
}

#ifndef PH_MASK
#define PH_MASK 0x3ff
#endif
__global__ void __launch_bounds__(512, 2) mega_fwd(Params p) {
    extern __shared__ __attribute__((aligned(16))) unsigned char lds_raw[];
    Ctx F;
    F.lds = (LAS unsigned char*)lds_raw; F.P = F.lds + LDS_P;
    F.tid = threadIdx.x; F.lane = F.tid & 63; F.wave = __builtin_amdgcn_readfirstlane(F.tid >> 6);
    F.G = gridDim.x; { const int bx = blockIdx.x; F.vcu = (F.G % 8 == 0) ? (bx % 8) * (F.G / 8) + bx / 8 : bx; }
    F.kp = (const CAS Params*)__builtin_amdgcn_kernarg_segment_ptr();
    for (int u = F.tid; u < LDS_P / 4; u += 512) ((LAS unsigned*)F.lds)[u] = 0u;
    __syncthreads();
    (void)xcd_barrier_post((unsigned*)p.ws + CW_BAR + p.li * XCD_BAR_WORDS, (volatile LAS unsigned*)(F.lds + 16), F.tid);

#ifdef FP8_SELFTEST
    if (blockIdx.x == 0 && F.wave == 0) {
        typedef int v8i_ __attribute__((ext_vector_type(8)));
        const int lane = F.lane, gq = lane >> 4;
        float factor = 1.0f;
        {
            v8i_ a, b; for (int i = 0; i < 8; ++i) { a[i] = 0x38383838; b[i] = 0x38383838; }
            f32x4 d = {0.f, 0.f, 0.f, 0.f}; const int s1 = 0x7f7f7f7f;
            asm volatile("v_mfma_scale_f32_16x16x128_f8f6f4 %0, %1, %2, %0, %3, %4 op_sel_hi:[0,0,0]\n\ts_nop 15\n\ts_nop 15" : "+v"(d) : "v"(a), "v"(b), "v"(s1), "v"(s1));
            if (!(d[0] == 128.f && d[3] == 128.f)) factor += 0.1f;
            f32x4 d2 = {0.f, 0.f, 0.f, 0.f}; const int s2 = 0x79797979;
            asm volatile("v_mfma_scale_f32_16x16x128_f8f6f4 %0, %1, %2, %0, %3, %4 op_sel_hi:[0,0,0]\n\ts_nop 15\n\ts_nop 15" : "+v"(d2) : "v"(a), "v"(b), "v"(s2), "v"(s1));
            if (!(d2[0] == 2.f && d2[3] == 2.f)) factor += 0.2f; }
        {
            v8i_ a, b; for (int i = 0; i < 8; ++i) { a[i] = 0; b[i] = 0; }
            if (gq == 1) { a[1] = 0x00003800; b[1] = 0x00003800; }
            f32x4 d = {0.f, 0.f, 0.f, 0.f}; const int s1 = 0x7f7f7f7f;
            asm volatile("v_mfma_scale_f32_16x16x128_f8f6f4 %0, %1, %2, %0, %3, %4 op_sel_hi:[0,0,0]\n\ts_nop 15\n\ts_nop 15" : "+v"(d) : "v"(a), "v"(b), "v"(s1), "v"(s1));
            if (!(d[0] == 1.f && d[1] == 1.f && d[2] == 1.f && d[3] == 1.f)) factor += 0.4f; }
        {
            const unsigned wv = pk4_fp8(1.0f, 0.5f, 1.5f, 448.f);
            if (wv != 0x7e3c3038u) factor += 0.8f; }
        if (lane == 0) ((float*)p.ws)[CW_CNT + 4000] = factor;
    }
#endif
    const int lo = p.ph_lo, hi = p.ph_hi;
#define IN(k) (((PH_MASK >> ((k) % 10)) & 1) && lo <= (k) && (k) < hi)
#define SEAM(k) do { if ((k) + 1 < hi) grid_seam(F); } while (0)
#pragma unroll 1
    for (int l = 0; l < 2; ++l) {
        const int pb = l * 10;
        if (IN(pb + 0)) {
#ifdef DUP_CONV
            phase_convert(F, l, 0);
#endif
            phase_convert(F, l, 0); SEAM(pb + 0); }
        if (IN(pb + 1)) {
#ifdef DUP_INPROJ
            phase_inproj(F);
#endif
            phase_inproj(F); SEAM(pb + 1); }
        if (IN(pb + 2)) { phase_kv(F, l); SEAM(pb + 2); }
        if (IN(pb + 3)) {
#ifdef DUP_MIXERS
            phase_mixers(F, l, 1 + (p.pad & 1), 0);
#endif
#ifdef DUP_ML
            mlstm_unit(F, l, F.vcu, 1 + (p.pad & 1));
#endif
#ifdef DUP_AT
            { const int b_ = F.vcu >> 5, j_ = F.vcu & 31;
#pragma unroll 1
              for (int ui = 0; ui < 4; ++ui) { const int qt = (ui == 0) ? j_ : (ui == 1) ? 63 - j_ : (ui == 2) ? 64 + j_ : 127 - j_; att_unit(F, b_, qt, 1 + (p.pad & 1), DUP_AT + (p.pad & 1)); } }
#endif
            phase_mixers(F, l, p.pad, 1); SEAM(pb + 3); }
        if (IN(pb + 4)) {
#ifdef DUP_MIX
            phase_mix_a(F); phase_mix_m(F);
#endif
            phase_mix_a(F); phase_mix_m(F); SEAM(pb + 4); }
        if (IN(pb + 5)) {
#ifdef DUP_OUT
            phase_out(F, l);
#endif
            phase_out(F, l); SEAM(pb + 5); }
        if (IN(pb + 6)) { phase_ln1(F, l); SEAM(pb + 6); }
        if (IN(pb + 7)) {
#ifdef DUP_MOEUP
            phase_moe_up(F, l);
#endif
#ifdef DUP_PLE
            phase_ple(F); phase_plegate(F);
#endif
#ifndef NO_MOEUP
            phase_moe_up(F, l);
#endif
#ifndef NO_PLE
            phase_ple(F);
#endif
#ifndef NO_PLEG
            phase_plegate(F);
#endif
            SEAM(pb + 7); }
        if (IN(pb + 8)) {
#ifdef DUP_DOWN
            phase_moe_down(F, l);
#endif
            phase_moe_down(F, l); SEAM(pb + 8); }
        if (IN(pb + 9)) { phase_ln2(F, l); if (l == 1) SEAM(pb + 9); }
    }
#undef IN
#undef SEAM
}

extern "C" void kernel_launch(void* const* d_in, const int* in_sizes, int n_in, void* d_out, int out_size, void* d_ws, size_t ws_size, hipStream_t stream) {
    static int grid = 0;
    if (grid == 0) {
        if (n_in != 23 || out_size != T * D || ws_size < WS_END) { fprintf(stderr, "kernel_launch: unexpected shapes (n_in %d, out %d, ws %zu, need %zu)\n", n_in, out_size, ws_size, (size_t)WS_END); grid = -1; return; }
        int dev = 0, cus = 0, per_cu = 0;
        if (hipGetDevice(&dev) != hipSuccess || hipDeviceGetAttribute(&cus, hipDeviceAttributeMultiprocessorCount, dev) != hipSuccess) { grid = -1; return; }
        if (hipFuncSetAttribute((const void*)mega_fwd, hipFuncAttributeMaxDynamicSharedMemorySize, LDS_BYTES) != hipSuccess) { fprintf(stderr, "kernel_launch: hipFuncSetAttribute failed\n"); grid = -1; return; }
        if (hipOccupancyMaxActiveBlocksPerMultiprocessor(&per_cu, (const void*)mega_fwd, 512, LDS_BYTES) != hipSuccess || per_cu < 1) fprintf(stderr, "kernel_launch: occupancy query says %d\n", per_cu);
        (void)hipGetLastError();
        grid = cus;
        if (grid != 256) fprintf(stderr, "kernel_launch: %d CUs (built for 256)\n", grid);
    }
    if (grid < 0) return;
    if (hipMemsetAsync((char*)d_ws + WS_CTL, 0, CTL_BYTES, stream) != hipSuccess) return;
    Params a{};
    for (int i = 0; i < 23; ++i) a.in[i] = (const float*)d_in[i];
    a.out = (float*)d_out; a.ws = (unsigned char*)d_ws;
    constexpr int NPH = 20;
    for (int li = 0; li < MK_N_LAUNCHES; ++li) {
        a.ph_lo = li * NPH / MK_N_LAUNCHES; a.ph_hi = (li + 1) * NPH / MK_N_LAUNCHES; a.li = li; a.pad = 0;
        hipLaunchKernelGGL(mega_fwd, dim3(grid), dim3(512), LDS_BYTES, stream, a);
    }
}
```

```cpp
#include <hip/hip_runtime.h>
#include <cstdio>
#include <cstdint>

#ifndef MK_N_LAUNCHES
#define MK_N_LAUNCHES 1
#endif

#define LAS __attribute__((address_space(3)))
typedef unsigned short bf16_t;
typedef short bf16x8 __attribute__((ext_vector_type(8)));
typedef short s16x4 __attribute__((ext_vector_type(4)));
typedef float f32x4 __attribute__((ext_vector_type(4)));
typedef float f32x2 __attribute__((ext_vector_type(2)));
typedef unsigned u32x4 __attribute__((ext_vector_type(4)));
typedef unsigned u32x2 __attribute__((ext_vector_type(2)));

constexpr int T = 16384, D = 2048, SEQ = 2048, NBATCH = 8;
constexpr int LDP = 13824;
constexpr int C_AQ = 0, C_MV = 2048, C_MO = 4096, C_GA = 6144, C_GM = 8192, C_MQ = 10240, C_MK = 11264, C_IQ = 12288, C_CKV = 13312,
              C_IK = 13568, C_IW = 13632, C_MI = 13648, C_MF = 13656, C_END = 13664;
constexpr int INW = 13664;
constexpr float LN_EPS = 1e-5f;
constexpr float DN_ALPHA = 1.41421356237f;
constexpr int NEXP = 16, ECAP = 16384, SLOT_ROWS = 36864;

constexpr size_t MiB = 1u << 20;
constexpr size_t WS_CTL = 0;
constexpr size_t WS_WIN = 1 * MiB, WS_WPA = 55 * MiB, WS_WPM = 63 * MiB, WS_WOUT = 71 * MiB, WS_WPG = 79 * MiB, WS_WGU = 87 * MiB, WS_WD = 151 * MiB,
                 WS_WPLE = 183 * MiB, WS_WUKV = 184 * MiB, WS_WRH = 184 * MiB + 128 * 1024, WS_WRL = 184 * MiB + 256 * 1024;
constexpr size_t WS_PB = 185 * MiB, WS_KV = 193 * MiB, WS_LIST = 201 * MiB, WS_WL = 202 * MiB, WS_TOK = 203 * MiB, WS_HB = 204 * MiB, WS_MIX = 268 * MiB, WS_PROJ = 332 * MiB;
constexpr size_t WS_PRE = WS_MIX  , WS_PLE = WS_PROJ + 128 * MiB, WS_HMID = WS_PROJ + 192 * MiB, WS_Y = WS_PROJ + 228 * MiB;
constexpr size_t WS_WIN8 = 764 * MiB, WS_HB8 = 791 * MiB;
constexpr size_t WS_WPG8 = 823 * MiB, WS_WGU8 = 827 * MiB;
constexpr size_t WS_WD8 = 859 * MiB;
constexpr size_t WS_WPA8 = 875 * MiB;
constexpr size_t WS_WPM8 = 879 * MiB, WS_WOUT8 = 883 * MiB;
constexpr size_t WS_END = 887 * MiB;
constexpr size_t WS_YM8 = WS_WIN;
static_assert(WS_Y + (size_t)SLOT_ROWS * 2048 * 2 <= WS_END, "ws map");
constexpr int CW_BAR = 4096, CW_CNT = 8192;
constexpr size_t CTL_BYTES = 65536;

constexpr int LDS_BYTES = 147456;
constexpr int LDS_P = 1024;

__device__ __forceinline__ float bf2f(unsigned b) { return __uint_as_float(b << 16); }
__device__ __forceinline__ unsigned f2bf(float f) { unsigned u = __float_as_uint(f); return (u + 0x7fffu + ((u >> 16) & 1u)) >> 16; }
typedef __bf16 bf16x2_t __attribute__((ext_vector_type(2)));
__device__ __forceinline__ unsigned pk2(float lo, float hi) { const f32x2 v = {lo, hi}; return __builtin_bit_cast(unsigned, __builtin_convertvector(v, bf16x2_t)); }
__device__ __forceinline__ unsigned pk4_fp8(float a, float b, float c, float d) { int w = 0; w = __builtin_amdgcn_cvt_pk_fp8_f32(a, b, w, false); w = __builtin_amdgcn_cvt_pk_fp8_f32(c, d, w, true); return (unsigned)w; }
__device__ __forceinline__ float qdq8(float x) { const int w = __builtin_amdgcn_cvt_pk_fp8_f32(x, x, 0, false); return __builtin_amdgcn_cvt_f32_fp8(w, 0); }
__device__ __forceinline__ void un8(const u32x2 w, float (&o)[8]) { const f32x2 a = __builtin_amdgcn_cvt_pk_f32_fp8((int)w.x, false), b = __builtin_amdgcn_cvt_pk_f32_fp8((int)w.x, true), c = __builtin_amdgcn_cvt_pk_f32_fp8((int)w.y, false), d = __builtin_amdgcn_cvt_pk_f32_fp8((int)w.y, true);
    o[0] = a[0]; o[1] = a[1]; o[2] = b[0]; o[3] = b[1]; o[4] = c[0]; o[5] = c[1]; o[6] = d[0]; o[7] = d[1]; }
#define bf2_fp8(w_, hi_) __builtin_bit_cast(unsigned, __builtin_amdgcn_cvt_scalef32_pk_bf16_fp8((w_), 1.0f, (hi_)))
__device__ __forceinline__ float lo16(unsigned w) { return __uint_as_float(w << 16); }
__device__ __forceinline__ float hi16(unsigned w) { return __uint_as_float(w & 0xffff0000u); }
__device__ __forceinline__ float sigmoidf_(float x) { return __builtin_amdgcn_rcpf(1.0f + __expf(-x)); }
__device__ __forceinline__ float shx(float v, int m, int lane) { return __int_as_float(__builtin_amdgcn_ds_bpermute((lane ^ m) << 2, __float_as_int(v))); }
__device__ __forceinline__ float shl_(float v, int src) { return __int_as_float(__builtin_amdgcn_ds_bpermute(src << 2, __float_as_int(v))); }
__device__ __forceinline__ float wave_sum(float v, int lane) {
#pragma unroll
    for (int o = 1; o < 64; o <<= 1) v += shx(v, o, lane);
    return v;
}
__device__ __forceinline__ int lane_id_() { int l; asm volatile("v_mbcnt_lo_u32_b32 %0, -1, 0\n\tv_mbcnt_hi_u32_b32 %0, -1, %0" : "=v"(l)); return l; }
#define LDS_WAIT() asm volatile("s_waitcnt lgkmcnt(0)" ::: "memory")

#define XB_TMO      128
#define XB_XCNT(j)  (256  + 64 * (j))
#define XB_XSUB(j)  (1280 + 64 * (j))
#define XB_XGEN(j)  (2304 + 64 * (j))
#define XB_TOP      3328
#define XB_TOPGEN   3392
#define XCD_BAR_WORDS 3456
#define XB_SPIN_CAP (1u << 18)
__device__ __forceinline__ unsigned xb_ld(unsigned* p)              { return __hip_atomic_load(p, __ATOMIC_RELAXED, __HIP_MEMORY_SCOPE_AGENT); }
__device__ __forceinline__ unsigned xb_add(unsigned* p, unsigned v) { return __hip_atomic_fetch_add(p, v, __ATOMIC_RELAXED, __HIP_MEMORY_SCOPE_AGENT); }
__device__ __forceinline__ unsigned xb_xcc_id() { return (unsigned)__builtin_amdgcn_s_getreg((3 << 11) | 20) & 0xFu; }
#define XB_SPIN(cond, bar) do { unsigned _sp = 0; while (cond) { __builtin_amdgcn_s_sleep(1); \
    if ((++_sp & 255u) == 0u) { if (xb_ld(&(bar)[XB_TMO])) break; if (_sp > XB_SPIN_CAP) { atomicAdd(&(bar)[XB_TMO], 1u); break; } } } } while (0)
struct XcdBarrier { unsigned* bar; unsigned x; volatile LAS unsigned* st; };
__device__ __forceinline__ XcdBarrier xcd_barrier_post(unsigned* bar, volatile LAS unsigned* st, int tid) {
    XcdBarrier b; b.bar = bar; b.x = xb_xcc_id(); b.st = st;
    if (tid == 0) (void)xb_add(&bar[XB_XCNT(b.x)], 1u);
    return b;
}
__device__ __forceinline__ void xcd_barrier_complete(unsigned* bar, unsigned x, unsigned& nloc, unsigned& nx) {
    const unsigned G = gridDim.x * gridDim.y * gridDim.z;
    unsigned sum, cnt, mine, sp = 0u;
    for (;;) {
        sum = 0u; cnt = 0u; mine = 0u;
#pragma unroll
        for (unsigned j = 0; j < 16; ++j) { const unsigned c = xb_ld(&bar[XB_XCNT(j)]); sum += c; cnt += (c > 0u) ? 1u : 0u; mine = (j == x) ? c : mine; }
        if (sum == G) break;
        __builtin_amdgcn_s_sleep(1);
        if ((++sp & 255u) == 0u) { if (xb_ld(&bar[XB_TMO])) break; if (sp > XB_SPIN_CAP) { atomicAdd(&bar[XB_TMO], 1u); break; } }
    }
    nloc = mine > 0u ? mine : 1u; nx = cnt > 0u ? cnt : 1u;
}
__device__ __forceinline__ void xcd_barrier(const XcdBarrier& b, int tid) {
    asm volatile("s_waitcnt vmcnt(0)" ::: "memory");
    __syncthreads();
    if (tid == 0) {
        unsigned* bar = b.bar;
        __builtin_amdgcn_s_waitcnt(0);
        unsigned nloc = b.st[0], nx = b.st[1];
        if (nloc == 0u) { xcd_barrier_complete(bar, b.x, nloc, nx); b.st[0] = nloc; b.st[1] = nx; }
        const unsigned old = xb_add(&bar[XB_XSUB(b.x)], 1u);
        const unsigned gen = old / nloc;
        if (old + 1u == (gen + 1u) * nloc) {
            __builtin_amdgcn_fence(__ATOMIC_RELEASE, "agent");
            asm volatile("s_waitcnt vmcnt(0)" ::: "memory");
            const unsigned og = xb_add(&bar[XB_TOP], 1u);
            const unsigned tg = og / nx;
            if (og + 1u == (tg + 1u) * nx) xb_add(&bar[XB_TOPGEN], 1u);
            else XB_SPIN(xb_ld(&bar[XB_TOPGEN]) == tg, bar);
            __builtin_amdgcn_fence(__ATOMIC_ACQUIRE, "agent");
            xb_add(&bar[XB_XGEN(b.x)], 1u);
            asm volatile("s_waitcnt vmcnt(0)" ::: "memory");
        } else {
            XB_SPIN(xb_ld(&bar[XB_XGEN(b.x)]) == gen, bar);
            __builtin_amdgcn_fence(__ATOMIC_ACQUIRE, "agent");
            asm volatile("s_waitcnt vmcnt(0)" ::: "memory");
        }
    }
    __syncthreads();
}

namespace pg8 {
constexpr int BM = 256, BK = 64, HALF = 128, HTB = HALF * BK * 2, STAGE_BYTES = 8 * HTB, NXCD = 8, WGM = 8;
__device__ __forceinline__ int lds_byte(int r, int c) { const int st = (r >> 4) * 2 + (c >> 5), rr = r & 15, cc = c & 31, ob = rr * 64 + cc * 2; return st * 1024 + (ob ^ (((ob >> 9) & 1) << 5)); }
__device__ __forceinline__ void stage_rc(int b, int& R, int& C) { const int st = b / 1024, sb = b % 1024, swz = sb ^ (((sb >> 9) & 1) << 5); R = (st >> 1) * 16 + swz / 64; C = (st & 1) * 32 + (swz % 64) / 2; }
__device__ __forceinline__ int perm32(int rho) { const int n = rho >> 4, i = rho & 15; return 8 * (i >> 2) + 4 * n + (i & 3); }

struct Unit { const char* A; const char* B; const int* idx; int nvalid, row0, col0, aux; };

constexpr int NFP8 = 10240;
__device__ __forceinline__ constexpr bool inproj_tile_fp8(int pn) { return pn < NFP8 / 256 || (pn >= 48 && pn <= 52); }
template <int M_, int N_, int LDA_, int LDB_, int MAP = 0, int BAL = 0> struct DenseSched {
    static constexpr int nM = M_ / BM, nN = MAP == 1 ? 24 : MAP == 2 ? 30 : MAP == 3 ? 45 : MAP == 4 ? 9 : N_ / BM, nwg = nM * nN;
    int G, c; const char* A; const char* B;
    __device__ __forceinline__ void init(int G_, int c_, const void* A_, const void* B_) { G = G_; c = c_; A = (const char*)A_; B = (const char*)B_; }
    __device__ __forceinline__ bool next(int i, Unit& u) const {
        int L = i * G + c;
        if (BAL == 1 && G == 256 && i >= 9) { if (c < 128 || i > 10) return false; L = 9 * 256 + (i - 9) * 128 + (c - 128); }
        if (BAL == 2 && G == 256 && i >= 10) { if (i == 10) { if (c < 64) return false; L = 2560 + (c - 64); } else if (i == 11) { if (c < 128) return false; L = 2752 + (c - 128); } else return false; }
        if (L >= nwg) return false;
        int wgid = L; { constexpr int q = nwg / NXCD, r = nwg % NXCD; const int xcd = wgid % NXCD, off = wgid / NXCD; wgid = (xcd < r ? xcd * (q + 1) : r * (q + 1) + (xcd - r) * q) + off; }
        constexpr int nig = WGM * nN; const int gid = wgid / nig, fm = gid * WGM, gsz = (nM - fm) < WGM ? (nM - fm) : WGM;
        const int pm = fm + ((wgid % nig) % gsz); int pn = (wgid % nig) / gsz;
        if (MAP == 1) pn = pn < 8 ? pn : pn + 16;
        if (MAP == 2) pn = pn < 16 ? pn + 8 : pn + 24;
        if (MAP == 3) pn = pn < 40 ? pn : pn + 8;
        if (MAP == 4) pn = pn < 8 ? pn + 40 : 53;
        u.A = A + (size_t)pm * ((size_t)BM * LDA_ * 2); u.B = B + (size_t)pn * ((size_t)BM * LDB_ * 2); u.idx = nullptr; u.nvalid = 256; u.row0 = pm * BM; u.col0 = pn * BM; u.aux = 0; return true;
    }
};
struct MoeSched {
    const LAS int* tpre; const LAS int* cnt; int NT, G, c, mode, bshift = 0;
    const char* Abase; const char* Bbase; const int* list;
    __device__ __forceinline__ bool next(int i, Unit& u) const {
        const int L = i * G + c; const int ntiles = __builtin_amdgcn_readfirstlane(tpre[16]);
        if (L >= ntiles * NT) return false;
        const int rt = L / NT, pn = L % NT; int e = 0;
#pragma unroll
        for (int k = 1; k < 16; ++k) e += (rt >= __builtin_amdgcn_readfirstlane(tpre[k])) ? 1 : 0;
        const int mt = rt - __builtin_amdgcn_readfirstlane(tpre[e]); const int ce = __builtin_amdgcn_readfirstlane(cnt[e]);
        int nv = ce - mt * 256; nv = nv > 256 ? 256 : nv;
        u.nvalid = nv; u.row0 = rt * 256; u.aux = e * ECAP + mt * 256;
        if (mode == 0) { u.A = Abase; u.idx = list + e * ECAP + mt * 256; u.B = Bbase + ((((size_t)e * 1024 + (size_t)pn * 256) * 2048 * 2) >> bshift); u.col0 = pn * 128; }
        else { u.A = Abase + (((size_t)rt * 256 * 512 * 2) >> bshift); u.idx = nullptr; u.B = Bbase + ((((size_t)e * 2048 + (size_t)pn * 256) * 512 * 2) >> bshift); u.col0 = pn * 256; }
        return true;
    }
};

#define EPI_REMAP() const int lane_ = fr + 16 * fq, fr2 = lane_ >> 2, fq2 = lane_ & 3, psrc = (fr2 + 16 * fq2) << 2
__device__ __forceinline__ u32x4 lperm4(const u32x4 w, const int psrc) { u32x4 r; r.x = (unsigned)__builtin_amdgcn_ds_bpermute(psrc, (int)w.x); r.y = (unsigned)__builtin_amdgcn_ds_bpermute(psrc, (int)w.y);
    r.z = (unsigned)__builtin_amdgcn_ds_bpermute(psrc, (int)w.z); r.w = (unsigned)__builtin_amdgcn_ds_bpermute(psrc, (int)w.w); return r; }
__device__ __forceinline__ f32x4 lperm4f(const f32x4 v, const int psrc) { return __builtin_bit_cast(f32x4, lperm4(__builtin_bit_cast(u32x4, v), psrc)); }
template <bool NT = false> struct EpiStoreBf16T {
    static constexpr bool PERM = true;
    bf16_t* O; int ldc;
    __device__ __forceinline__ void operator()(const f32x4 (&acc)[2][2][4][2], const Unit& u, int wr, int wc, int fr, int fq) const {
        EPI_REMAP();
        const int row0 = u.row0 + wr * 64 + fr2, col0 = u.col0 + wc * 32 + 8 * fq2;
#pragma unroll
        for (int ai = 0; ai < 2; ++ai)
#pragma unroll
            for (int m = 0; m < 4; ++m) { bf16_t* rowp = O + (size_t)(row0 + ai * HALF + m * 16) * ldc + col0;
#pragma unroll
                for (int bj = 0; bj < 2; ++bj) { const f32x4 v0 = acc[ai][bj][m][0], v1 = acc[ai][bj][m][1];
                    u32x4 w; w.x = pk2(v0[0], v0[1]); w.y = pk2(v0[2], v0[3]); w.z = pk2(v1[0], v1[1]); w.w = pk2(v1[2], v1[3]);
                    w = lperm4(w, psrc);
                    if (NT) __builtin_nontemporal_store(w, (u32x4*)(rowp + bj * HALF)); else *(u32x4*)(rowp + bj * HALF) = w; } }
    }
};
typedef EpiStoreBf16T<false> EpiStoreBf16;
typedef EpiStoreBf16T<true> EpiStoreBf16NT;
template <bool ADD> struct EpiGate {
    static constexpr bool PERM = true;
    bf16_t* O; int ldo; const bf16_t* gate; int ldg; unsigned char* O8; int ld8;
    __device__ __forceinline__ void operator()(const f32x4 (&acc)[2][2][4][2], const Unit& u, int wr, int wc, int fr, int fq) const {
        EPI_REMAP();
        const int row0 = u.row0 + wr * 64 + fr2, col0 = u.col0 + wc * 32 + 8 * fq2;
#pragma unroll
        for (int ai = 0; ai < 2; ++ai)
#pragma unroll
            for (int m = 0; m < 4; ++m) { const size_t r = (size_t)(row0 + ai * HALF + m * 16);
#pragma unroll
                for (int bj = 0; bj < 2; ++bj) { const f32x4 v0 = lperm4f(acc[ai][bj][m][0], psrc), v1 = lperm4f(acc[ai][bj][m][1], psrc);
                    const u32x4 gw = __builtin_nontemporal_load((const u32x4*)(gate + r * ldg + col0 + bj * HALF));
                    float o[8] = {0.f, 0.f, 0.f, 0.f, 0.f, 0.f, 0.f, 0.f};
                    if (ADD) { const u32x4 ow = *(const u32x4*)(O + r * ldo + col0 + bj * HALF);
                        o[0] = lo16(ow.x); o[1] = hi16(ow.x); o[2] = lo16(ow.y); o[3] = hi16(ow.y); o[4] = lo16(ow.z); o[5] = hi16(ow.z); o[6] = lo16(ow.w); o[7] = hi16(ow.w); }
                    o[0] += v0[0] * sigmoidf_(lo16(gw.x)); o[1] += v0[1] * sigmoidf_(hi16(gw.x)); o[2] += v0[2] * sigmoidf_(lo16(gw.y)); o[3] += v0[3] * sigmoidf_(hi16(gw.y));
                    o[4] += v1[0] * sigmoidf_(lo16(gw.z)); o[5] += v1[1] * sigmoidf_(hi16(gw.z)); o[6] += v1[2] * sigmoidf_(lo16(gw.w)); o[7] += v1[3] * sigmoidf_(hi16(gw.w));
                    if (O8) {
#pragma unroll
                        for (int e = 0; e < 8; ++e) o[e] = fminf(fmaxf(o[e], -440.f), 440.f);
                        u32x2 w8; w8.x = pk4_fp8(o[0], o[1], o[2], o[3]); w8.y = pk4_fp8(o[4], o[5], o[6], o[7]);
                        *(u32x2*)(O8 + r * ld8 + col0 + bj * HALF) = w8; }
                    else { u32x4 w; w.x = pk2(o[0], o[1]); w.y = pk2(o[2], o[3]); w.z = pk2(o[4], o[5]); w.w = pk2(o[6], o[7]);
                        *(u32x4*)(O + r * ldo + col0 + bj * HALF) = w; } }
                asm volatile("" ::: "memory"); }
    }
};
struct EpiPleGate {
    static constexpr bool PERM = true;
    bf16_t* P; int ld;
    __device__ __forceinline__ void operator()(const f32x4 (&acc)[2][2][4][2], const Unit& u, int wr, int wc, int fr, int fq) const {
        EPI_REMAP();
        const int row0 = u.row0 + wr * 64 + fr2, col0 = u.col0 + wc * 32 + 8 * fq2;
#pragma unroll
        for (int ai = 0; ai < 2; ++ai)
#pragma unroll
            for (int m = 0; m < 4; ++m) { bf16_t* rowp = P + (size_t)(row0 + ai * HALF + m * 16) * ld + col0;
#pragma unroll
                for (int bj = 0; bj < 2; ++bj) { const f32x4 v0 = lperm4f(acc[ai][bj][m][0], psrc), v1 = lperm4f(acc[ai][bj][m][1], psrc);
                    const u32x4 pw = *(const u32x4*)(rowp + bj * HALF);
                    u32x4 w; w.x = pk2(lo16(pw.x) * sigmoidf_(v0[0]), hi16(pw.x) * sigmoidf_(v0[1])); w.y = pk2(lo16(pw.y) * sigmoidf_(v0[2]), hi16(pw.y) * sigmoidf_(v0[3]));
                    w.z = pk2(lo16(pw.z) * sigmoidf_(v1[0]), hi16(pw.z) * sigmoidf_(v1[1])); w.w = pk2(lo16(pw.w) * sigmoidf_(v1[2]), hi16(pw.w) * sigmoidf_(v1[3]));
                    *(u32x4*)(rowp + bj * HALF) = w; }
                asm volatile("" ::: "memory"); }
    }
};
struct EpiSwiglu {
    static constexpr bool PERM = true;
    unsigned char* H; const float* wl;
    __device__ __forceinline__ void operator()(const f32x4 (&acc)[2][2][4][2], const Unit& u, int wr, int wc, int fr, int fq) const {
        EPI_REMAP();
        const int rl0 = wr * 64 + fr;
#pragma unroll
        for (int ai = 0; ai < 2; ++ai)
#pragma unroll
            for (int m = 0; m < 4; ++m) { const int rl = rl0 + ai * HALF + m * 16; const float cw = rl < u.nvalid ? 16.f * wl[u.aux + rl] : 0.f;
                const f32x4 g0 = acc[ai][0][m][0], g1 = acc[ai][0][m][1], u0 = acc[ai][1][m][0], u1 = acc[ai][1][m][1];
                float o[8];
#pragma unroll
                for (int j = 0; j < 4; ++j) { o[j] = fminf(fmaxf(g0[j] * sigmoidf_(g0[j]) * u0[j] * cw, -440.f), 440.f); o[4 + j] = fminf(fmaxf(g1[j] * sigmoidf_(g1[j]) * u1[j] * cw, -440.f), 440.f); }
                u32x2 w; w.x = (unsigned)__builtin_amdgcn_ds_bpermute(psrc, (int)pk4_fp8(o[0], o[1], o[2], o[3])); w.y = (unsigned)__builtin_amdgcn_ds_bpermute(psrc, (int)pk4_fp8(o[4], o[5], o[6], o[7]));
                *(u32x2*)(H + (size_t)(u.row0 + wr * 64 + fr2 + ai * HALF + m * 16) * 512 + u.col0 + wc * 32 + 8 * fq2) = w;
                asm volatile("" ::: "memory"); }
    }
};
struct EpiResBf16 {
    static constexpr bool PERM = true;
    bf16_t* O; const bf16_t* base; float alpha; int ldc;
    __device__ __forceinline__ void operator()(const f32x4 (&acc)[2][2][4][2], const Unit& u, int wr, int wc, int fr, int fq) const {
        EPI_REMAP();
        const int row0 = u.row0 + wr * 64 + fr2, col0 = u.col0 + wc * 32 + 8 * fq2;
#pragma unroll
        for (int ai = 0; ai < 2; ++ai)
#pragma unroll
            for (int m = 0; m < 4; ++m) { const size_t off = (size_t)(row0 + ai * HALF + m * 16) * ldc + col0;
#pragma unroll
                for (int bj = 0; bj < 2; ++bj) { const f32x4 v0 = lperm4f(acc[ai][bj][m][0], psrc), v1 = lperm4f(acc[ai][bj][m][1], psrc);
                    const u32x4 bw = *(const u32x4*)(base + off + bj * HALF);
                    u32x4 w; w.x = pk2(alpha * lo16(bw.x) + v0[0], alpha * hi16(bw.x) + v0[1]); w.y = pk2(alpha * lo16(bw.y) + v0[2], alpha * hi16(bw.y) + v0[3]);
                    w.z = pk2(alpha * lo16(bw.z) + v1[0], alpha * hi16(bw.z) + v1[1]); w.w = pk2(alpha * lo16(bw.w) + v1[2], alpha * hi16(bw.w) + v1[3]);
                    *(u32x4*)(O + off + bj * HALF) = w; }
                asm volatile("" ::: "memory"); }
    }
};

template <class Epi, class Sched, bool GATHER, bool ALIGN_EPI, int K, int lda, int ldb, bool FP8 = false, int SCL_A = 0x7f7f7f7f, int SCL_B = 0x79797979>
__device__ __forceinline__ void gemm_phase(LAS unsigned char* lds, const int tid_in, LAS unsigned* toktab, const Sched& S, const Epi& E) {
    int tid_ = tid_in; asm volatile("" : "+v"(tid_));
    const int tid = tid_, wid = __builtin_amdgcn_readfirstlane(tid >> 6), lane = tid & 63, wr = wid >> 2, wc = wid & 3, fr = lane & 15, fq = lane >> 4;
    constexpr int nt = K / BK;
    unsigned voffA[2], voffB[2]; int rA[2]; unsigned cA2[2];
#pragma unroll
    for (int i = 0; i < 2; ++i) { int R, C; stage_rc(tid * 16 + i * 8192, R, C); const int Rb = Epi::PERM ? ((R & ~31) + perm32(R & 31)) : R;
        voffA[i] = (unsigned)(R * lda + C) * 2u; voffB[i] = (unsigned)(Rb * ldb + C) * 2u; rA[i] = R; cA2[i] = (unsigned)C * 2u; }
    constexpr size_t kstep = (size_t)(BK * 2);
    constexpr size_t hstepA = (size_t)HALF * lda * 2, hstepB = (size_t)HALF * ldb * 2;
    const unsigned ldsw = (unsigned)wid * 1024u;
    const int aoff = lds_byte(wr * 64 + fr, fq * 8), boff = lds_byte(wc * 32 + fr, fq * 8);
#define PG8_SA(b, h) (((b) * 2 + (h)) * HTB)
#define PG8_SB(b, h) ((4 + (b) * 2 + (h)) * HTB)
#define PG8_STAGE_B(bufoff, gbase) do { _Pragma("unroll") for (int _i = 0; _i < 2; ++_i) \
        __builtin_amdgcn_global_load_lds((const unsigned*)((const char*)(gbase) + voffB[_i]), (LAS unsigned*)(lds + (bufoff) + ldsw + _i * 8192), 16, 0, 0); } while (0)
#define PG8_STAGE_A(bufoff, gbase, h, nx) do { _Pragma("unroll") for (int _i = 0; _i < 2; ++_i) { \
        const char* _g = GATHER ? (const char*)(gbase) : (const char*)(gbase) + (h) * hstepA; \
        const unsigned _o = GATHER ? (toktab[(((nx) ? (tpar ^ 1) : tpar) << 8) + (h) * HALF + rA[_i]] + cA2[_i]) : voffA[_i]; \
        __builtin_amdgcn_global_load_lds((const unsigned*)(_g + _o), (LAS unsigned*)(lds + (bufoff) + ldsw + _i * 8192), 16, 0, 0); } } while (0)
#define PG8_LDA(dst, b, h) do { _Pragma("unroll") for (int m = 0; m < 4; ++m) _Pragma("unroll") for (int k = 0; k < 2; ++k) dst[m][k] = *(const LAS bf16x8*)(lds + PG8_SA(b, h) + aoff + m * 2048 + k * 1024); } while (0)
#define PG8_LDB(dst, b, h) do { _Pragma("unroll") for (int n = 0; n < 2; ++n) _Pragma("unroll") for (int k = 0; k < 2; ++k) dst[n][k] = *(const LAS bf16x8*)(lds + PG8_SB(b, h) + boff + n * 2048 + k * 1024); } while (0)
#define PG8_MMA(ai, bj, At, Bt) do { __builtin_amdgcn_s_setprio(1); _Pragma("unroll") for (int m = 0; m < 4; ++m) _Pragma("unroll") for (int n = 0; n < 2; ++n) { \
        if constexpr (FP8) { typedef int v4i_ __attribute__((ext_vector_type(4))); typedef int v8i_ __attribute__((ext_vector_type(8))); \
            const v8i_ b8 = __builtin_shufflevector(__builtin_bit_cast(v4i_, Bt[n][0]), __builtin_bit_cast(v4i_, Bt[n][1]), 0, 1, 2, 3, 4, 5, 6, 7); \
            const v8i_ a8 = __builtin_shufflevector(__builtin_bit_cast(v4i_, At[m][0]), __builtin_bit_cast(v4i_, At[m][1]), 0, 1, 2, 3, 4, 5, 6, 7); \
            asm volatile("v_mfma_scale_f32_16x16x128_f8f6f4 %0, %1, %2, %0, %3, %4 op_sel_hi:[0,0,0]" : "+v"(acc[ai][bj][m][n]) : "v"(b8), "v"(a8), "v"(sclB), "v"(sclA)); }     \
        else { _Pragma("unroll") for (int k = 0; k < 2; ++k) acc[ai][bj][m][n] = __builtin_amdgcn_mfma_f32_16x16x32_bf16(Bt[n][k], At[m][k], acc[ai][bj][m][n], 0, 0, 0); } } \
        __builtin_amdgcn_s_setprio(0); } while (0)
#define PG8_WAIT_V(n) asm volatile("s_waitcnt vmcnt(" #n ")" ::: "memory")
#define PG8_WAIT_L(n) asm volatile("s_waitcnt lgkmcnt(" #n ")" ::: "memory")
#define PG8_BAR __builtin_amdgcn_s_barrier()
#define PG8_SCHED __builtin_amdgcn_sched_barrier(0)
#define PG8_LOAD_OFFS(uu, par) do { if (tid < 256) { const int _tok = tid < (uu).nvalid ? (uu).idx[tid] : 0; toktab[((par) << 8) + tid] = (unsigned)(_tok * lda) * 2u; } } while (0)
    int tpar = 0;
    const int sclB = SCL_B, sclA = SCL_A; (void)sclA; (void)sclB;
    Unit cur, nxt; int ui = 0;
    if (!S.next(0, cur)) return;
    f32x4 acc[2][2][4][2];
#pragma unroll
    for (int a = 0; a < 2; ++a)
#pragma unroll
        for (int b = 0; b < 2; ++b)
#pragma unroll
            for (int m = 0; m < 4; ++m)
#pragma unroll
                for (int n = 0; n < 2; ++n) acc[a][b][m][n] = (f32x4){0.f, 0.f, 0.f, 0.f};
    bf16x8 At[4][2], B0[2][2], B1[2][2];
    const char* cA = cur.A; const char* cB = cur.B;
    if constexpr (GATHER) { PG8_LOAD_OFFS(cur, 0); asm volatile("s_waitcnt lgkmcnt(0)" ::: "memory"); __builtin_amdgcn_s_barrier(); }
    PG8_STAGE_B(PG8_SB(0, 0), cB); PG8_STAGE_B(PG8_SB(0, 1), cB + hstepB); PG8_STAGE_A(PG8_SA(0, 0), cA, 0, false); PG8_STAGE_A(PG8_SA(0, 1), cA, 1, false);
    if (wr == 1) PG8_BAR;
    PG8_WAIT_V(2); PG8_BAR;
    PG8_STAGE_B(PG8_SB(1, 0), cB + kstep); PG8_STAGE_A(PG8_SA(1, 0), cA + kstep, 0, false); PG8_STAGE_B(PG8_SB(1, 1), cB + hstepB + kstep);
    PG8_WAIT_V(6); PG8_BAR;
    for (;;) {
        const bool has_next = S.next(ui + 1, nxt);
        const char* nA = has_next ? nxt.A : cA; const char* nB = has_next ? nxt.B : cB;
        if constexpr (GATHER) { if (has_next) { PG8_LOAD_OFFS(nxt, tpar ^ 1); } else if (tid < 256) toktab[((tpar ^ 1) << 8) + tid] = toktab[(tpar << 8) + tid]; }
#pragma unroll 1
        for (int t = 0; t < nt; t += 2) {
            const bool last = (t == nt - 2);
            const char* a1 = cA + (size_t)(t + 1) * kstep;
            const char* a2 = last ? nA : cA + (size_t)(t + 2) * kstep; const char* b2 = last ? nB : cB + (size_t)(t + 2) * kstep;
            const char* a3 = a2 + kstep; const char* b3 = b2 + kstep;
            PG8_LDB(B0, 0, 0); PG8_LDB(B1, 0, 1); PG8_SCHED; PG8_LDA(At, 0, 0); PG8_STAGE_A(PG8_SA(1, 1), a1, 1, false);
            PG8_WAIT_V(8); PG8_WAIT_L(0); PG8_BAR; PG8_MMA(0, 0, At, B0); PG8_MMA(0, 1, At, B1); PG8_BAR; PG8_SCHED;
            PG8_LDA(At, 0, 1); PG8_STAGE_B(PG8_SB(0, 0), b2); PG8_STAGE_B(PG8_SB(0, 1), b2 + hstepB); PG8_STAGE_A(PG8_SA(0, 0), a2, 0, last);
            PG8_WAIT_V(8); PG8_WAIT_L(0); PG8_BAR; PG8_MMA(1, 0, At, B0); PG8_MMA(1, 1, At, B1); PG8_BAR; PG8_SCHED;
            PG8_LDB(B0, 1, 0); PG8_LDB(B1, 1, 1); PG8_SCHED; PG8_LDA(At, 1, 0); PG8_STAGE_A(PG8_SA(0, 1), a2, 1, last);
            PG8_WAIT_V(8); PG8_WAIT_L(0); PG8_BAR; PG8_MMA(0, 0, At, B0); PG8_MMA(0, 1, At, B1); PG8_BAR; PG8_SCHED;
            PG8_LDA(At, 1, 1); PG8_STAGE_B(PG8_SB(1, 0), b3); PG8_STAGE_B(PG8_SB(1, 1), b3 + hstepB); PG8_STAGE_A(PG8_SA(1, 0), a3, 0, last);
            PG8_WAIT_V(8); PG8_WAIT_L(0); PG8_BAR; PG8_MMA(1, 0, At, B0); PG8_MMA(1, 1, At, B1); PG8_BAR; PG8_SCHED;
        }
        if constexpr (ALIGN_EPI) { if (wr == 0) PG8_BAR; }
        { int te_ = tid; asm volatile("" : "+v"(te_)); const int le_ = te_ & 63; E(acc, cur, wr, wc, le_ & 15, le_ >> 4); }
        if (!has_next) break;
#pragma unroll
        for (int a = 0; a < 2; ++a)
#pragma unroll
            for (int b = 0; b < 2; ++b)
#pragma unroll
                for (int m = 0; m < 4; ++m)
#pragma unroll
                    for (int n = 0; n < 2; ++n) acc[a][b][m][n] = (f32x4){0.f, 0.f, 0.f, 0.f};
        cur = nxt; cA = nA; cB = nB; ++ui;
        if constexpr (GATHER) tpar ^= 1;
        if constexpr (ALIGN_EPI) { if (wr == 1) PG8_BAR; }
    }
    PG8_WAIT_V(0);
    if constexpr (!ALIGN_EPI) { if (wr == 0) PG8_BAR; }
    PG8_BAR;
#undef PG8_SA
#undef PG8_SB
#undef PG8_STAGE_A
#undef PG8_STAGE_B
#undef PG8_LDA
#undef PG8_LDB
#undef PG8_MMA
#undef PG8_WAIT_V
#undef PG8_WAIT_L
#undef PG8_BAR
#undef PG8_SCHED
#undef PG8_LOAD_OFFS
}
}

struct Params { const float* in[23]; float* out; unsigned char* ws; int ph_lo, ph_hi, li, pad; };
#define CAS __attribute__((address_space(4)))
struct Ctx {
    LAS unsigned char* lds; LAS unsigned char* P;
    int tid, lane, wave, vcu, G;
    const CAS Params* kp;
};
#define PHASE_ENTER() const CAS Params* q_ = F0.kp; asm volatile("" : "+s"(q_)); int tid_ = F0.wave * 64 + lane_id_(); asm volatile("" : "+v"(tid_)); \
    Ctx F = F0; F.tid = tid_; F.lane = tid_ & 63; F.wave = __builtin_amdgcn_readfirstlane(tid_ >> 6); \
    unsigned char* const ws = q_->ws; unsigned* const ctl = (unsigned*)ws; (void)ctl
#define PIN(i) (q_->in[i])
enum { I_X = 0, I_P, I_WIN, I_KVN, I_WUKV, I_MIB, I_MFB, I_WPA, I_WPM, I_WOUT, I_LN1G, I_LN1B, I_WGRP, I_BGRP, I_WEXP, I_BEXP, I_WGATE, I_WUP, I_WDOWN, I_WPLE, I_WPG, I_LN2G, I_LN2B };

__device__ __forceinline__ int win_src_col(int n) {
    if (n < 2048) return n;
    if (n < 4096) return 5456 + (n - 2048);
    if (n < 6144) return 7504 + (n - 4096);
    if (n < 8192) return 9568 + (n - 6144);
    if (n < 10240) return 11616 + (n - 8192);
    if (n < 11264) return 3408 + (n - 10240);
    if (n < 12288) return 4432 + (n - 11264);
    if (n < 13312) return 2304 + (n - 12288);
    if (n < 13568) return 2048 + (n - 13312);
    if (n < 13632) return 3328 + (n - 13568);
    if (n < 13648) return 3392 + (n - 13632);
    if (n < 13656) return 9552 + (n - 13648);
    if (n < 13664) return 9560 + (n - 13656);
    return -1;
}
struct CvItem { const float* src; int ldsrc, srccol; bf16_t* dst; int dstld; unsigned char* dst8; };
__device__ __forceinline__ void cv_load(const CvItem& I, f32x4 (&v)[16], int lane) {
    const int r = lane >> 4;
#pragma unroll
    for (int i = 0; i < 16; ++i) v[i] = I.srccol >= 0 ? __builtin_nontemporal_load((const f32x4*)(I.src + (size_t)(4 * i + r) * I.ldsrc + I.srccol)) : (f32x4){0.f, 0.f, 0.f, 0.f};
}
__device__ __forceinline__ void cv_store(const CvItem& I, const f32x4 (&v)[16], LAS bf16_t* scr, int lane) {
    const int r = lane >> 4, c4 = lane & 15;
#pragma unroll
    for (int i = 0; i < 16; ++i) { const int k = 4 * i + r;
#pragma unroll
        for (int e = 0; e < 4; ++e) scr[(4 * c4 + e) * 66 + k] = (bf16_t)f2bf(v[i][e]); }
    LDS_WAIT(); asm volatile("" ::: "memory");
    const int ch = lane & 7;
#pragma unroll
    for (int j = 0; j < 8; ++j) { const int n = (lane >> 3) + 8 * j; const LAS unsigned* sp = (const LAS unsigned*)(scr + n * 66 + ch * 8);
        u32x4 o; o.x = sp[0]; o.y = sp[1]; o.z = sp[2]; o.w = sp[3];
        if (I.dst) *(u32x4*)(I.dst + (size_t)n * I.dstld + 8 * ch) = o;
        if (I.dst8) { u32x2 o8; o8.x = pk4_fp8(lo16(o.x) * 64.f, hi16(o.x) * 64.f, lo16(o.y) * 64.f, hi16(o.y) * 64.f); o8.y = pk4_fp8(lo16(o.z) * 64.f, hi16(o.z) * 64.f, lo16(o.w) * 64.f, hi16(o.w) * 64.f);
            *(u32x2*)(I.dst8 + (size_t)n * I.dstld + 8 * ch) = o8; } }
    LDS_WAIT(); asm volatile("" ::: "memory");
}
namespace cv { constexpr int N0 = 216 * 32, N1 = 32 * 32, N5 = 16 * 16 * 32, N6 = 16 * 32 * 8, N7 = 32 * 4, N8 = 4 * 4, NIT = N0 + 4 * N1 + N5 + N6 + N7 + N8; }
#define CV_DECODE(I, it_) do { int r = (it_); \
        if (r < cv::N0) { const int kb = r / 216, grp = r % 216; const int n = grp * 64 + 4 * c4; const bool f8 = pg8::inproj_tile_fp8(grp >> 2); \
            I.src = PIN(I_WIN) + (size_t)l * 2048 * INW + (size_t)kb * 64 * INW; I.ldsrc = INW; I.srccol = win_src_col(n); I.dstld = 2048; \
            I.dst = f8 ? (bf16_t*)nullptr : (bf16_t*)(ws + WS_WIN) + (size_t)grp * 64 * 2048 + kb * 64; I.dst8 = f8 ? ws + WS_WIN8 + (size_t)grp * 64 * 2048 + kb * 64 : (unsigned char*)nullptr; break; } \
        r -= cv::N0; \
        if (r < 4 * cv::N1) { const int which = r / cv::N1, rr = r % cv::N1, kb = rr / 32, grp = rr % 32; \
            const float* src_ = which == 0 ? PIN(I_WPA) : which == 1 ? PIN(I_WPM) : which == 2 ? PIN(I_WOUT) : PIN(I_WPG); \
            I.src = src_ + (size_t)l * 2048 * 2048 + (size_t)kb * 64 * 2048; I.ldsrc = 2048; I.srccol = grp * 64 + 4 * c4; I.dstld = 2048; \
            I.dst = which == 1 ? (bf16_t*)(ws + WS_WPM) + (size_t)grp * 64 * 2048 + kb * 64 : (bf16_t*)nullptr; \
            I.dst8 = ws + (which == 0 ? WS_WPA8 : which == 1 ? WS_WPM8 : which == 2 ? WS_WOUT8 : WS_WPG8) + (size_t)grp * 64 * 2048 + kb * 64; break; } \
        r -= 4 * cv::N1; \
        if (r < cv::N5) { const int e = r / 512, rr = r % 512, kb = rr / 16, grp = rr % 16; const int drow = grp * 64, tile = drow / 256, w = drow % 256; const bool isup = w >= 128; \
            I.src = (isup ? PIN(I_WUP) : PIN(I_WGATE)) + ((size_t)l * 16 + e) * 2048 * 512 + (size_t)kb * 64 * 512; I.ldsrc = 512; I.srccol = tile * 128 + (isup ? w - 128 : w) + 4 * c4; I.dstld = 2048; \
            I.dst = nullptr; I.dst8 = ws + WS_WGU8 + ((size_t)e * 1024 + drow) * 2048 + kb * 64; break; } \
        r -= cv::N5; \
        if (r < cv::N6) { const int e = r / 256, rr = r % 256, kb = rr / 32, grp = rr % 32; \
            I.src = PIN(I_WDOWN) + ((size_t)l * 16 + e) * 512 * 2048 + (size_t)kb * 64 * 2048; I.ldsrc = 2048; I.srccol = grp * 64 + 4 * c4; I.dstld = 512; \
            I.dst = nullptr; I.dst8 = ws + WS_WD8 + ((size_t)e * 2048 + grp * 64) * 512 + kb * 64; break; } \
        r -= cv::N6; \
        if (r < cv::N7) { const int kb = r / 32, grp = r % 32; \
            I.src = PIN(I_WPLE) + (size_t)l * 256 * 2048 + (size_t)kb * 64 * 2048; I.ldsrc = 2048; I.srccol = grp * 64 + 4 * c4; I.dstld = 256; \
            I.dst = (bf16_t*)(ws + WS_WPLE) + (size_t)grp * 64 * 256 + kb * 64; I.dst8 = nullptr; break; } \
        r -= cv::N7; \
        { const int kb = r / 4, grp = r % 4; \
            I.src = PIN(I_WUKV) + (size_t)l * 256 * 256 + (size_t)kb * 64 * 256; I.ldsrc = 256; I.srccol = grp * 64 + 4 * c4; I.dstld = 256; \
            I.dst = (bf16_t*)(ws + WS_WUKV) + (size_t)grp * 64 * 256 + kb * 64; I.dst8 = nullptr; } } while (0)
__device__ __forceinline__ void phase_convert(const Ctx& F0, int l, int late) {
    PHASE_ENTER();
    LAS bf16_t* scr = (LAS bf16_t*)(F.P + F.wave * 8448);
    const int gw = F.vcu * 8 + F.wave, NGW = F.G * 8, lane = F.lane, c4 = lane & 15;
    {
        constexpr int NA = cv::N0 + cv::N8, NB = cv::NIT - NA;
#define CV_MAP(j_) (late ? cv::N0 + (j_) : ((j_) < cv::N0 ? (j_) : (j_) - cv::N0 + (cv::NIT - cv::N8)))
        const int nit = late ? NB : NA;
        CvItem I0, I1; f32x4 va[16], vb[16];
        int it = gw;
        if (it < nit) { CV_DECODE(I0, CV_MAP(it)); cv_load(I0, va, lane); }
#pragma unroll 1
        for (; it < nit; it += NGW) {
            const int itn = it + NGW;
            if (itn < nit) { CV_DECODE(I1, CV_MAP(itn)); cv_load(I1, vb, lane); }
            cv_store(I0, va, scr, lane);
            I0 = I1;
#pragma unroll
            for (int i = 0; i < 16; ++i) va[i] = vb[i];
        }
#undef CV_MAP
    }
    if (late) return;
    const size_t gt = (size_t)F.vcu * 512 + F.tid, NT = (size_t)F.G * 512;
    for (size_t i = gt; i < 32 * 2048; i += NT) { const int c = (int)(i / 2048), k = (int)(i % 2048);
        float w = 0.f; if (c < 4) w = PIN(I_WGRP)[((size_t)l * 2048 + k) * 4 + c]; else if (c < 20) w = PIN(I_WEXP)[((size_t)l * 2048 + k) * 16 + (c - 4)];
        const unsigned h = f2bf(w); const float rem = w - bf2f(h);
        ((bf16_t*)(ws + WS_WRH))[i] = (bf16_t)h; ((bf16_t*)(ws + WS_WRL))[i] = (bf16_t)f2bf(rem); }
    { const f32x4* src = (const f32x4*)(PIN(I_P) + (size_t)l * T * 256); u32x4* dst = (u32x4*)(ws + WS_PB);
      for (size_t i = gt; i < (size_t)T * 256 / 8; i += NT) { const f32x4 a = __builtin_nontemporal_load(src + 2 * i), b = __builtin_nontemporal_load(src + 2 * i + 1); u32x4 o; o.x = pk2(a[0], a[1]); o.y = pk2(a[2], a[3]); o.z = pk2(b[0], b[1]); o.w = pk2(b[2], b[3]); dst[i] = o; } }
    if (l == 0) { const f32x4* src = (const f32x4*)PIN(I_X); u32x4* dst = (u32x4*)(ws + WS_HB); u32x2* dst8 = (u32x2*)(ws + WS_HB8);
      for (size_t i0 = gt; i0 < (size_t)T * D / 8; i0 += 4 * NT) { f32x4 a[4], b[4];
#pragma unroll
        for (int u = 0; u < 4; ++u) { const size_t i = i0 + u * NT; a[u] = __builtin_nontemporal_load(src + 2 * i); b[u] = __builtin_nontemporal_load(src + 2 * i + 1); }
#pragma unroll
        for (int u = 0; u < 4; ++u) { const size_t i = i0 + u * NT; u32x4 o; o.x = pk2(a[u][0], a[u][1]); o.y = pk2(a[u][2], a[u][3]); o.z = pk2(b[u][0], b[u][1]); o.w = pk2(b[u][2], b[u][3]); dst[i] = o;
            u32x2 o8; o8.x = pk4_fp8(a[u][0], a[u][1], a[u][2], a[u][3]); o8.y = pk4_fp8(b[u][0], b[u][1], b[u][2], b[u][3]); dst8[i] = o8;
            } } }
}

__device__ __forceinline__ void phase_kv(const Ctx& F0, int l) {
    PHASE_ENTER();
    const bf16_t* proj = (const bf16_t*)(ws + WS_PROJ); const bf16_t* W = (const bf16_t*)(ws + WS_WUKV); bf16_t* kv = (bf16_t*)(ws + WS_KV);
    const float* gn = q_->in[I_KVN] + l * 256;
    const int lane = F.lane, n16 = lane & 15, g = lane >> 4;
    const int gw = F.vcu * 8 + F.wave, NGW = F.G * 8;
    const int psrc = (4 * n16 + g) << 2, lr = lane >> 2, lp = lane & 3;
    for (int task = gw; task < T / 8; task += NGW) {
        const int t0 = (task >> 1) * 16, nt0 = (task & 1) * 8;
        const bf16_t* xr = proj + (size_t)(t0 + lr) * LDP + C_CKV + 8 * lp;
        u32x4 raw[8]; float ss = 0.f;
#pragma unroll
        for (int ks = 0; ks < 8; ++ks) { raw[ks] = pg8::lperm4(*(const u32x4*)(xr + ks * 32), psrc);
            const float a0 = lo16(raw[ks].x), a1 = hi16(raw[ks].x), a2 = lo16(raw[ks].y), a3 = hi16(raw[ks].y), a4 = lo16(raw[ks].z), a5 = hi16(raw[ks].z), a6 = lo16(raw[ks].w), a7 = hi16(raw[ks].w);
            ss += (a0 * a0 + a1 * a1) + (a2 * a2 + a3 * a3) + (a4 * a4 + a5 * a5) + (a6 * a6 + a7 * a7); }
        ss += shx(ss, 16, lane); ss += shx(ss, 32, lane);
        const float rstd = 1.0f / sqrtf(ss * (1.0f / 256.0f) + LN_EPS);
        bf16x8 xb[8];
#pragma unroll
        for (int ks = 0; ks < 8; ++ks) { const f32x4 g0 = *(const f32x4*)(gn + ks * 32 + 8 * g), g1 = *(const f32x4*)(gn + ks * 32 + 8 * g + 4);
            u32x4 o; o.x = pk2(lo16(raw[ks].x) * rstd * g0[0], hi16(raw[ks].x) * rstd * g0[1]); o.y = pk2(lo16(raw[ks].y) * rstd * g0[2], hi16(raw[ks].y) * rstd * g0[3]);
            o.z = pk2(lo16(raw[ks].z) * rstd * g1[0], hi16(raw[ks].z) * rstd * g1[1]); o.w = pk2(lo16(raw[ks].w) * rstd * g1[2], hi16(raw[ks].w) * rstd * g1[3]);
            xb[ks] = __builtin_bit_cast(bf16x8, o); }
#pragma unroll 2
        for (int nt = 0; nt < 8; ++nt) { const int ntile = nt0 + nt;
            const bf16_t* wr = W + (size_t)(ntile * 16 + lr) * 256 + 8 * lp;
            f32x4 d = {0.f, 0.f, 0.f, 0.f};
#pragma unroll
            for (int ks = 0; ks < 8; ++ks) { const bf16x8 a = __builtin_bit_cast(bf16x8, pg8::lperm4(*(const u32x4*)(wr + ks * 32), psrc)); d = __builtin_amdgcn_mfma_f32_16x16x32_bf16(a, xb[ks], d, 0, 0, 0); }
            const unsigned pk = pk4_fp8(fminf(fmaxf(d[0], -440.f), 440.f), fminf(fmaxf(d[1], -440.f), 440.f), fminf(fmaxf(d[2], -440.f), 440.f), fminf(fmaxf(d[3], -440.f), 440.f));
            *(unsigned*)((unsigned char*)kv + (size_t)(t0 + lr) * 256 + ntile * 16 + 4 * lp) = (unsigned)__builtin_amdgcn_ds_bpermute((lr + 16 * lp) << 2, (int)pk);
        }
    }
}

namespace ml {
constexpr int QS = 0, KS = 17408, VS0 = 34816, VSZ = 11264, PS0 = VS0 + 2 * VSZ, PSZ = 9216, CT = PS0 + 2 * PSZ, TB = CT + 21760, TF = TB + 8192, TA = TF + 8192, TI = TA + 8192, TE = TI + 8192, SC = TE + 8192;
constexpr int QLD = 136, VLD = 88, PLD = 72, CTLD = 136;
static_assert(SC + 1024 <= LDS_BYTES - LDS_P, "mlstm lds");
}
__device__ __forceinline__ float scan_sum(float v, int lane) {
#pragma unroll
    for (int o = 1; o < 64; o <<= 1) { const float t = shl_(v, lane >= o ? lane - o : lane); if (lane >= o) v += t; }
    return v;
}
__device__ __forceinline__ float scan_max(float v, int lane) {
#pragma unroll
    for (int o = 1; o < 64; o <<= 1) { const float t = shl_(v, lane >= o ? lane - o : lane); if (lane >= o) v = fmaxf(v, t); }
    return v;
}
__device__ __forceinline__ s16x4 trrd(const LAS unsigned char* p) { return __builtin_amdgcn_ds_read_tr16_b64_v4i16((LAS s16x4*)p); }
__device__ __forceinline__ void mlstm_unit(const Ctx& F0, int l, int unit, int dry) {
    PHASE_ENTER();
    using namespace ml;
    const int b = unit >> 5, h = (unit >> 2) & 7, dq = unit & 3;
    bf16_t* proj = (bf16_t*)(ws + WS_PROJ);
    LAS unsigned char* P = F.P;
    LAS bf16_t* Qs = (LAS bf16_t*)(P + QS); LAS bf16_t* Ks = (LAS bf16_t*)(P + KS); LAS bf16_t* Ct = (LAS bf16_t*)(P + CT);
    LAS float* tB = (LAS float*)(P + TB); LAS float* tF = (LAS float*)(P + TF); LAS float* tA = (LAS float*)(P + TA); LAS float* tI = (LAS float*)(P + TI); LAS float* tE = (LAS float*)(P + TE);
    LAS float* sc = (LAS float*)(P + SC);
    const int tid = F.tid, lane = F.lane, w = F.wave, n16 = lane & 15, g = lane >> 4, qr = (lane & 15) >> 2, pr = lane & 3;
    const float ib = PIN(I_MIB)[l * 8 + h], fb = PIN(I_MFB)[l * 8 + h];
    const size_t rowb = (size_t)b * SEQ;
    for (int c = w; c < 32; c += 8) {
        const size_t t = rowb + c * 64 + lane;
        const float li = bf2f(proj[t * LDP + C_MI + h]) + ib;
        const float x = bf2f(proj[t * LDP + C_MF + h]) + fb;
        const float lf = fminf(x, 0.f) - log1pf(__expf(-fabsf(x)));
        const float bc = scan_sum(lf, lane);
        const float blast = shl_(bc, 63);
        const float Bv = li - bc;
        const float pm = scan_max(Bv, lane);
        const float maxB = shl_(pm, 63);
        tB[c * 64 + lane] = Bv; tF[c * 64 + lane] = __expf(Bv - maxB); tA[c * 64 + lane] = bc; tI[c * 64 + lane] = pm;
        if (lane == 0) { sc[c] = blast; sc[32 + c] = blast + maxB; }
    }
    for (int i = tid; i < 80 * CTLD / 2; i += 512) ((LAS unsigned*)Ct)[i] = 0u;
    for (int i = tid; i < 2 * 64 * 8; i += 512) { const int bufi = i >> 9, row = (i >> 3) & 63, cw = i & 7; ((LAS unsigned*)(P + VS0 + bufi * VSZ + row * VLD * 2 + 128))[cw] = 0x3f803f80u; }
    __syncthreads();
    if (tid == 0) { float m = 0.f;
        for (int c = 0; c < 32; ++c) { const float bl = sc[c], ae = sc[32 + c]; sc[64 + c] = m; const float mn = fmaxf(bl + m, ae); sc[96 + c] = __expf(bl + m - mn); sc[128 + c] = __expf(ae - mn); m = mn; } }
    __syncthreads();
    for (int c = w; c < 32; c += 8) {
        const float bc = tA[c * 64 + lane], pm = tI[c * 64 + lane], mp = sc[64 + c];
        const float mrow = fmaxf(bc + mp, bc + pm);
        tA[c * 64 + lane] = bc - mrow; tI[c * 64 + lane] = __expf(bc + mp - mrow); tE[c * 64 + lane] = __expf(-mrow);
    }
    const float qscale = 0.08838834764831845f;
    f32x4 Cst[5];
#pragma unroll
    for (int i = 0; i < 5; ++i) Cst[i] = (f32x4){0.f, 0.f, 0.f, 0.f};
    const int jt = w & 3, hp = w >> 2;
    const int srow0 = tid >> 4, sch = tid & 15, vrow = tid >> 3, vch = tid & 7;
    u32x4 rq[2], rk[2], rv;
#define ML_LOAD(cc) do { const size_t tb_ = rowb + (size_t)(cc) * 64; \
        _Pragma("unroll") for (int i = 0; i < 2; ++i) { rq[i] = *(const u32x4*)(proj + (tb_ + srow0 + 32 * i) * LDP + C_MQ + h * 128 + sch * 8); rk[i] = *(const u32x4*)(proj + (tb_ + srow0 + 32 * i) * LDP + C_MK + h * 128 + sch * 8); } \
        rv = *(const u32x4*)(proj + (tb_ + vrow) * LDP + C_MV + h * 256 + dq * 64 + vch * 8); } while (0)
    ML_LOAD(0);
    __syncthreads();
#pragma unroll 1
    for (int c = 0; c < 32; ++c) {
        const size_t tb = rowb + c * 64;
        LAS unsigned char* Vb = P + VS0 + (c & 1) * VSZ; LAS bf16_t* Ps = (LAS bf16_t*)(P + PS0 + (c & 1) * PSZ);
#pragma unroll
        for (int i = 0; i < 2; ++i) { *(LAS u32x4*)(Qs + (srow0 + 32 * i) * QLD + sch * 8) = rq[i]; *(LAS u32x4*)(Ks + (srow0 + 32 * i) * QLD + sch * 8) = rk[i]; }
        *(LAS u32x4*)(Vb + vrow * VLD * 2 + vch * 16) = rv;
        unsigned short mo[2][4];
#pragma unroll
        for (int r = 0; r < 4; ++r)
#pragma unroll
            for (int i = 0; i < 2; ++i) mo[i][r] = proj[(tb + jt * 16 + 4 * g + r) * LDP + C_MO + h * 256 + dq * 64 + (2 * hp + i) * 16 + n16];
        if (c + 1 < 32) ML_LOAD(c + 1);
        __syncthreads();
#pragma unroll
        for (int x = 0; x < 2; ++x) { const int st = 2 * hp + x;
            f32x4 d = {0.f, 0.f, 0.f, 0.f};
#pragma unroll
            for (int ks = 0; ks < 4; ++ks) { const bf16x8 a = *(const LAS bf16x8*)(Ks + (st * 16 + n16) * QLD + ks * 32 + 8 * g); const bf16x8 bq = *(const LAS bf16x8*)(Qs + (jt * 16 + n16) * QLD + ks * 32 + 8 * g);
                d = __builtin_amdgcn_mfma_f32_16x16x32_bf16(a, bq, d, 0, 0, 0); }
            const int j = jt * 16 + n16; const float Aj = tA[c * 64 + j];
            const f32x4 b4 = *(const LAS f32x4*)(tB + c * 64 + st * 16 + 4 * g);
            float o[4];
#pragma unroll
            for (int r = 0; r < 4; ++r) { const int s_ = st * 16 + 4 * g + r; o[r] = (s_ <= j) ? __expf(Aj + b4[r]) * d[r] * qscale : 0.f; }
            u32x2 wv; wv.x = pk2(o[0], o[1]); wv.y = pk2(o[2], o[3]);
            *(LAS u32x2*)(Ps + j * PLD + st * 16 + 4 * g) = wv; }
        f32x4 acc5[3];
#pragma unroll
        for (int i = 0; i < 3; ++i) { const int dt = (i < 2) ? (2 * hp + i) : 4;
            f32x4 d = {0.f, 0.f, 0.f, 0.f};
#pragma unroll
            for (int ks = 0; ks < 4; ++ks) { const bf16x8 a = *(const LAS bf16x8*)(Qs + (jt * 16 + n16) * QLD + ks * 32 + 8 * g); const bf16x8 bc = *(const LAS bf16x8*)(Ct + (dt * 16 + n16) * CTLD + ks * 32 + 8 * g);
                d = __builtin_amdgcn_mfma_f32_16x16x32_bf16(a, bc, d, 0, 0, 0); }
            acc5[i] = d; }
        { const float dec = sc[96 + c], scl = sc[128 + c];
            f32x4 dn[5];
#pragma unroll
            for (int dt = 0; dt < 5; ++dt) dn[dt] = (f32x4){0.f, 0.f, 0.f, 0.f};
#pragma unroll
            for (int ks = 0; ks < 2; ++ks) { const int s0 = ks * 32 + 8 * g;
                const LAS unsigned char* ka = (const LAS unsigned char*)Ks + (s0 + qr) * QLD * 2 + (w * 16 + 4 * pr) * 2;
                const s16x4 k0 = trrd(ka), k1 = trrd(ka + 4 * QLD * 2);
                const f32x4 f0 = *(const LAS f32x4*)(tF + c * 64 + s0), f1 = *(const LAS f32x4*)(tF + c * 64 + s0 + 4);
                u32x4 aw; aw.x = pk2(bf2f((unsigned short)k0[0]) * f0[0], bf2f((unsigned short)k0[1]) * f0[1]); aw.y = pk2(bf2f((unsigned short)k0[2]) * f0[2], bf2f((unsigned short)k0[3]) * f0[3]);
                aw.z = pk2(bf2f((unsigned short)k1[0]) * f1[0], bf2f((unsigned short)k1[1]) * f1[1]); aw.w = pk2(bf2f((unsigned short)k1[2]) * f1[2], bf2f((unsigned short)k1[3]) * f1[3]);
                const bf16x8 a = __builtin_bit_cast(bf16x8, aw);
#pragma unroll
                for (int dt = 0; dt < 5; ++dt) { const LAS unsigned char* va = Vb + (s0 + qr) * VLD * 2 + (dt * 16 + 4 * pr) * 2;
                    const s16x4 v0 = trrd(va), v1 = trrd(va + 4 * VLD * 2);
                    const bf16x8 bv = __builtin_shufflevector(v0, v1, 0, 1, 2, 3, 4, 5, 6, 7);
                    dn[dt] = __builtin_amdgcn_mfma_f32_16x16x32_bf16(a, bv, dn[dt], 0, 0, 0); } }
#pragma unroll
            for (int dt = 0; dt < 5; ++dt) Cst[dt] = Cst[dt] * dec + dn[dt] * scl; }
        __syncthreads();
#pragma unroll
        for (int dt = 0; dt < 5; ++dt) { u32x2 wv; wv.x = pk2(Cst[dt][0], Cst[dt][1]); wv.y = pk2(Cst[dt][2], Cst[dt][3]); *(LAS u32x2*)(Ct + (dt * 16 + n16) * CTLD + w * 16 + 4 * g) = wv; }
        f32x4 acc4[3];
#pragma unroll
        for (int i = 0; i < 3; ++i) { const int dt = (i < 2) ? (2 * hp + i) : 4;
            f32x4 d = {0.f, 0.f, 0.f, 0.f};
#pragma unroll
            for (int ks = 0; ks < 2; ++ks) { const int s0 = ks * 32 + 8 * g;
                const bf16x8 a = *(const LAS bf16x8*)(Ps + (jt * 16 + n16) * PLD + ks * 32 + 8 * g);
                const LAS unsigned char* va = Vb + (s0 + qr) * VLD * 2 + (dt * 16 + 4 * pr) * 2;
                const s16x4 v0 = trrd(va), v1 = trrd(va + 4 * VLD * 2);
                const bf16x8 bv = __builtin_shufflevector(v0, v1, 0, 1, 2, 3, 4, 5, 6, 7);
                d = __builtin_amdgcn_mfma_f32_16x16x32_bf16(a, bv, d, 0, 0, 0); }
            acc4[i] = d; }
#pragma unroll
        for (int r = 0; r < 4; ++r) { const int j = jt * 16 + 4 * g + r; const float iw = tI[c * 64 + j] * qscale; const float den = iw * acc5[2][r] + acc4[2][r];
            const float dn_ = fmaxf(fabsf(den), tE[c * 64 + j]); const float inv = 1.0f / dn_;
#pragma unroll
            for (int i = 0; i < 2; ++i) { const float num = iw * acc5[i][r] + acc4[i][r]; const float hv = num * inv;
                bf16_t* op = proj + (tb + j) * LDP + C_MO + h * 256 + dq * 64 + (2 * hp + i) * 16 + n16;
                const float yv = hv * sigmoidf_(bf2f(mo[i][r])); (void)op;
                if (!dry || yv == 1.2345e30f) { const float yc = fminf(fmaxf(yv * 0.5f, -440.f), 440.f);
                    *(unsigned char*)(ws + WS_YM8 + (tb + j) * D + h * 256 + dq * 64 + (2 * hp + i) * 16 + n16) = (unsigned char)(__builtin_amdgcn_cvt_pk_fp8_f32(yc, yc, 0, false) & 0xff); } } }
    }
#undef ML_LOAD
    __syncthreads();
}

namespace at {
constexpr int S_OFF = 0, Q_OFF = 65536, QPITCH = 2080, L_OFF = Q_OFF + 16 * QPITCH, W_OFF = L_OFF + 8192, C_OFF = W_OFF + 1024, QL_OFF = C_OFF + 64, QLP = 288;
static_assert(QL_OFF + 16 * QLP <= LDS_BYTES - LDS_P && (L_OFF % 16) == 0 && (QL_OFF % 16) == 0, "att lds");
}
__device__ __forceinline__ int cnt8_ge(unsigned k0, unsigned k1, unsigned k2, unsigned k3, unsigned k4, unsigned k5, unsigned k6, unsigned k7, unsigned cand) {
    unsigned long long m0, m1, m2, m3, m4, m5, m6, m7;
    asm("v_cmp_ge_u32_e64 %0, %8, %16\n\tv_cmp_ge_u32_e64 %1, %9, %16\n\tv_cmp_ge_u32_e64 %2, %10, %16\n\tv_cmp_ge_u32_e64 %3, %11, %16\n\t"
        "v_cmp_ge_u32_e64 %4, %12, %16\n\tv_cmp_ge_u32_e64 %5, %13, %16\n\tv_cmp_ge_u32_e64 %6, %14, %16\n\tv_cmp_ge_u32_e64 %7, %15, %16\n\ts_nop 1"
        : "=s"(m0), "=s"(m1), "=s"(m2), "=s"(m3), "=s"(m4), "=s"(m5), "=s"(m6), "=s"(m7)
        : "v"(k0), "v"(k1), "v"(k2), "v"(k3), "v"(k4), "v"(k5), "v"(k6), "v"(k7), "v"(cand));
    return __builtin_popcountll(m0) + __builtin_popcountll(m1) + __builtin_popcountll(m2) + __builtin_popcountll(m3) + __builtin_popcountll(m4) + __builtin_popcountll(m5) + __builtin_popcountll(m6) + __builtin_popcountll(m7);
}
__device__ __forceinline__ void att_unit(const Ctx& F0, int b, int qt, int dry, int stop) {
    PHASE_ENTER();
    using namespace at;
    bf16_t* proj = (bf16_t*)(ws + WS_PROJ);
    const unsigned char* kvb = (const unsigned char*)(ws + WS_KV); constexpr int KVP = 256;
    LAS unsigned char* P = F.P;
    LAS _Float16* S = (LAS _Float16*)(P + S_OFF); LAS unsigned char* IQ = P + Q_OFF; LAS unsigned short* LST = (LAS unsigned short*)(P + L_OFF); LAS float* WT = (LAS float*)(P + W_OFF); LAS int* CN = (LAS int*)(P + C_OFF);
    const int tid = F.tid, lane = F.lane, w = F.wave, n16 = lane & 15, g = lane >> 4;
    const int t0 = qt * 16; const size_t T0 = (size_t)b * SEQ + t0; const size_t rowb = (size_t)b * SEQ;
    if (tid < 256) { const int hh = tid >> 4, q = tid & 15; WT[hh * 16 + q] = bf2f(proj[(T0 + q) * LDP + C_IW + hh]); }
#pragma unroll
    for (int i = 0; i < 4; ++i) { const int id = tid + 512 * i, row = id >> 7, ch = id & 127;
        *(LAS u32x4*)(IQ + row * QPITCH + ch * 16) = *(const u32x4*)(proj + (T0 + row) * LDP + C_IQ + ch * 8); }
    __syncthreads();
    { const int q = tid >> 5, c2 = (tid & 31) * 2; float s0 = 0.f, s1 = 0.f;
#pragma unroll
      for (int hh = 0; hh < 16; ++hh) { const unsigned u = *(const LAS unsigned*)(IQ + q * QPITCH + hh * 128 + c2 * 2); const float wv = WT[hh * 16 + q]; s0 += wv * lo16(u); s1 += wv * hi16(u); }
      const unsigned hi = pk2(s0, s1);
      *(LAS unsigned*)(P + QL_OFF + q * QLP + c2 * 2) = hi;
      *(LAS unsigned*)(P + QL_OFF + q * QLP + 128 + c2 * 2) = pk2(s0 - lo16(hi), s1 - hi16(hi)); }
    __syncthreads();
    const int nkt = qt + 1, ngr = (nkt + 3) >> 2;
    {
        bf16x8 bk[4][2], bkn[4][2];
#define ATT_LOADB(dst, gi_) do { _Pragma("unroll") for (int x = 0; x < 4; ++x) _Pragma("unroll") for (int ks = 0; ks < 2; ++ks) \
            dst[x][ks] = *(const bf16x8*)((const unsigned char*)proj + (unsigned)((((unsigned)rowb + (unsigned)(((gi_) * 4 + x) * 16 + (lane >> 2))) * (unsigned)LDP + (unsigned)(C_IK + ks * 32 + 8 * (lane & 3))) * 2u)); } while (0)
        const int kperm1 = (4 * n16 + g) << 2;
        if (w < ngr) ATT_LOADB(bkn, w);
#pragma unroll 1
        for (int gi = w; gi < ngr; gi += 8) {
            const int gn = (gi + 8 < ngr) ? gi + 8 : gi;
#pragma unroll
            for (int x = 0; x < 4; ++x)
#pragma unroll
                for (int ks = 0; ks < 2; ++ks) { const u32x4 s_ = __builtin_bit_cast(u32x4, bkn[x][ks]); u32x4 d_;
                    d_.x = (unsigned)__builtin_amdgcn_ds_bpermute(kperm1, (int)s_.x); d_.y = (unsigned)__builtin_amdgcn_ds_bpermute(kperm1, (int)s_.y); d_.z = (unsigned)__builtin_amdgcn_ds_bpermute(kperm1, (int)s_.z); d_.w = (unsigned)__builtin_amdgcn_ds_bpermute(kperm1, (int)s_.w);
                    bk[x][ks] = __builtin_bit_cast(bf16x8, d_); }
            ATT_LOADB(bkn, gn);
            f32x4 sacc[4];
            { bf16x8 ql[4];
#pragma unroll
              for (int i = 0; i < 4; ++i) ql[i] = *(const LAS bf16x8*)(P + QL_OFF + n16 * QLP + i * 64 + 16 * g);
#pragma unroll
              for (int x = 0; x < 4; ++x) sacc[x] = __builtin_amdgcn_mfma_f32_16x16x32_bf16(ql[0], bk[x][0], (f32x4){0.f, 0.f, 0.f, 0.f}, 0, 0, 0);
#pragma unroll
              for (int x = 0; x < 4; ++x) sacc[x] = __builtin_amdgcn_mfma_f32_16x16x32_bf16(ql[1], bk[x][1], sacc[x], 0, 0, 0);
#pragma unroll
              for (int x = 0; x < 4; ++x) sacc[x] = __builtin_amdgcn_mfma_f32_16x16x32_bf16(ql[2], bk[x][0], sacc[x], 0, 0, 0);
#pragma unroll
              for (int x = 0; x < 4; ++x) sacc[x] = __builtin_amdgcn_mfma_f32_16x16x32_bf16(ql[3], bk[x][1], sacc[x], 0, 0, 0); }
            bf16x8 qa[2][2]; f32x4 wq[2]; f32x4 dd[2][4];
#define ATT_LDQA(buf, hh_) do { qa[buf][0] = *(const LAS bf16x8*)(IQ + n16 * QPITCH + (hh_) * 128 + 16 * g); qa[buf][1] = *(const LAS bf16x8*)(IQ + n16 * QPITCH + (hh_) * 128 + 64 + 16 * g); } while (0)
#define ATT_LDW(buf, hh_) do { wq[buf] = *(const LAS f32x4*)(WT + (hh_) * 16 + 4 * g); } while (0)
#define ATT_MMA(buf) do { _Pragma("unroll") for (int x = 0; x < 4; ++x) dd[buf][x] = __builtin_amdgcn_mfma_f32_16x16x32_bf16(qa[buf][0], bk[x][0], (f32x4){0.f, 0.f, 0.f, 0.f}, 0, 0, 0); \
            _Pragma("unroll") for (int x = 0; x < 4; ++x) dd[buf][x] = __builtin_amdgcn_mfma_f32_16x16x32_bf16(qa[buf][1], bk[x][1], dd[buf][x], 0, 0, 0); } while (0)
#define ATT_FOLD(buf) do { _Pragma("unroll") for (int x = 0; x < 4; ++x) _Pragma("unroll") for (int r = 0; r < 4; ++r) { float t_ = __builtin_fmaf(wq[buf][r], __builtin_fabsf(dd[buf][x][r]), sacc[x][r]); asm("" : "+v"(t_)); sacc[x][r] = t_; } } while (0)
            ATT_LDQA(0, 0); ATT_LDW(0, 0); ATT_LDQA(1, 1);
            ATT_MMA(0);
#pragma unroll 1
            for (int hp = 0; hp < 7; ++hp) { const int h0 = 2 * hp;
                ATT_MMA(1);
                ATT_LDQA(0, h0 + 2); ATT_LDW(1, h0 + 1);
                ATT_FOLD(0);
                ATT_MMA(0);
                ATT_LDQA(1, h0 + 3); ATT_LDW(0, h0 + 2);
                ATT_FOLD(1);
            }
            ATT_MMA(1); ATT_LDW(1, 15);
            ATT_FOLD(0);
            ATT_FOLD(1);
#undef ATT_LDQA
#undef ATT_LDW
#undef ATT_MMA
#undef ATT_FOLD
#pragma unroll
            for (int x = 0; x < 4; ++x) { const int kt = gi * 4 + x; if (kt < nkt) {
#pragma unroll
                for (int r = 0; r < 4; ++r) S[(4 * g + r) * 2048 + kt * 16 + n16] = (_Float16)sacc[x][r]; } }
        }
#undef ATT_LOADB
    }
    __syncthreads();
    if (stop == 1) return;
    u32x4 qwp[2][4];
#pragma unroll
    for (int qq = 0; qq < 2; ++qq)
#pragma unroll
        for (int j = 0; j < 4; ++j) qwp[qq][j] = *(const u32x4*)(proj + (T0 + 2 * w + qq) * LDP + C_AQ + n16 * 128 + g * 32 + j * 8);
#pragma unroll 1
    for (int qq = 0; qq < 2; ++qq) {
        const int q = 2 * w + qq, t = t0 + q, nv = t + 1;
        LAS unsigned short* lst = LST + q * 256;
        if (nv <= 256) {
#pragma unroll
            for (int i = 0; i < 4; ++i) { const int pos = lane + 64 * i; lst[pos] = (unsigned short)(pos < nv ? pos : 0); }
            if (lane == 0) CN[q] = nv;
        } else {
            unsigned key[32];
            const LAS unsigned short* srow = (const LAS unsigned short*)S + q * 2048;
            const int ng = (nv + 511) >> 9;
#pragma unroll
            for (int G = 0; G < 4; ++G) {
                if (G < ng) {
#pragma unroll
                    for (int j = 8 * G; j < 8 * G + 8; ++j) { const int idx = j * 64 + lane; const unsigned u = srow[idx];
                        const unsigned k = (u & 0x8000u) ? (~u & 0xffffu) : (u | 0x8000u); key[j] = idx < nv ? k : 0u; }
                } else {
#pragma unroll
                    for (int j = 8 * G; j < 8 * G + 8; ++j) key[j] = 0u;
                }
            }
#define ATT_CNT(cand_) (cnt8_ge(key[0], key[1], key[2], key[3], key[4], key[5], key[6], key[7], cand_) + (ng > 1 ? cnt8_ge(key[8], key[9], key[10], key[11], key[12], key[13], key[14], key[15], cand_) : 0) \
                      + (ng > 2 ? cnt8_ge(key[16], key[17], key[18], key[19], key[20], key[21], key[22], key[23], cand_) : 0) + (ng > 3 ? cnt8_ge(key[24], key[25], key[26], key[27], key[28], key[29], key[30], key[31], cand_) : 0))
            unsigned Tk = 0u;
#pragma unroll 1
            for (int bit = 15; bit >= 0; --bit) { const unsigned cand = Tk | (1u << bit);
                const int cge = ATT_CNT(cand);
                if (cge >= 256) Tk = cand;
                if (cge == 256) break; }
            const int cgt = ATT_CNT(Tk + 1u);
#undef ATT_CNT
            int base = 0, tbase = cgt;
#pragma unroll
            for (int G = 0; G < 4; ++G) {
                if (G < ng) {
#pragma unroll
                    for (int j = 8 * G; j < 8 * G + 8; ++j) { const bool sg = key[j] > Tk, st = key[j] == Tk; const unsigned long long m = __ballot(sg), m2 = __ballot(st);
                        const int pg = (int)__builtin_amdgcn_mbcnt_hi((unsigned)(m >> 32), __builtin_amdgcn_mbcnt_lo((unsigned)m, (unsigned)base));
                        const int pe = (int)__builtin_amdgcn_mbcnt_hi((unsigned)(m2 >> 32), __builtin_amdgcn_mbcnt_lo((unsigned)m2, (unsigned)tbase));
                        if (sg || (st && pe < 256)) lst[sg ? pg : pe] = (unsigned short)(j * 64 + lane);
                        base += __builtin_popcountll(m); tbase += __builtin_popcountll(m2); }
                }
            }
            if (lane == 0) CN[q] = 256;
        }
    }
    typedef int v8i_ __attribute__((ext_vector_type(8)));
    v8i_ qf8p[2];
#pragma unroll
    for (int qq = 0; qq < 2; ++qq)
#pragma unroll
        for (int j = 0; j < 4; ++j) { const u32x4 v = qwp[qq][j]; qf8p[qq][2 * j] = (int)pk4_fp8(lo16(v.x), hi16(v.x), lo16(v.y), hi16(v.y)); qf8p[qq][2 * j + 1] = (int)pk4_fp8(lo16(v.z), hi16(v.z), lo16(v.w), hi16(v.w)); }
    __syncthreads();
    if (stop == 2) return;
    LAS unsigned char* VS = P + S_OFF + w * 8192;
    const unsigned rowb32 = (unsigned)rowb;
    const int qr = (lane & 15) >> 2, pr = lane & 3;
#pragma unroll 1
    for (int qq = 0; qq < 2; ++qq) {
        const int q = 2 * w + qq, t = t0 + q; const int cnt = __builtin_amdgcn_readfirstlane(CN[q]);
        const LAS unsigned short* lst = LST + q * 256;
        bf16_t* qrow = proj + (T0 + q) * LDP + C_AQ;
#ifdef ATT_SKIP3
        { for (int c = lane; c < 2048; c += 64) qrow[c] = (bf16_t)f2bf((float)lst[c & 255] * 1e-3f + (float)cnt * 1e-3f); continue; }
#endif
        v8i_ qf8;
#pragma unroll
        for (int j = 0; j < 8; ++j) qf8[j] = qq ? qf8p[1][j] : qf8p[0][j];
        const float scale = 0.08838834764831845f;
        const float slope2 = exp2f(-0.5f * (float)(n16 + 1)) * 11.313708498984761f;
        f32x4 lg[16];
#ifndef ATT_KB
#define ATT_KB 8
#endif
        u32x4 kf[2][ATT_KB][2];
        const int kperm = (4 * n16 + g) << 2;
#define ATT_LOADK(bt, buf) do { _Pragma("unroll") for (int x = 0; x < ATT_KB; ++x) { const unsigned sidx = lst[((bt) * ATT_KB + x) * 16 + (lane >> 2)]; const unsigned char* kr = kvb + (unsigned)((rowb32 + sidx) * 256u + (unsigned)(lane & 3) * 32u); \
            kf[buf][x][0] = *(const u32x4*)kr; kf[buf][x][1] = *(const u32x4*)(kr + 16); } } while (0)
        ATT_LOADK(0, 0); ATT_LOADK(1, 1);
        __builtin_amdgcn_sched_barrier(0);
#pragma unroll
        for (int bt = 0; bt < 16 / ATT_KB; ++bt) {
#pragma unroll
            for (int x = 0; x < ATT_KB; ++x) { const int kt2 = bt * ATT_KB + x;
                typedef int v4i_ __attribute__((ext_vector_type(4)));
                const u32x4 ka = kf[bt & 1][x][0], kb = kf[bt & 1][x][1]; v8i_ k8;
                k8[0] = __builtin_amdgcn_ds_bpermute(kperm, (int)ka.x); k8[1] = __builtin_amdgcn_ds_bpermute(kperm, (int)ka.y); k8[2] = __builtin_amdgcn_ds_bpermute(kperm, (int)ka.z); k8[3] = __builtin_amdgcn_ds_bpermute(kperm, (int)ka.w);
                k8[4] = __builtin_amdgcn_ds_bpermute(kperm, (int)kb.x); k8[5] = __builtin_amdgcn_ds_bpermute(kperm, (int)kb.y); k8[6] = __builtin_amdgcn_ds_bpermute(kperm, (int)kb.z); k8[7] = __builtin_amdgcn_ds_bpermute(kperm, (int)kb.w);
                const f32x4 d = __builtin_amdgcn_mfma_scale_f32_16x16x128_f8f6f4(k8, qf8, (f32x4){0.f, 0.f, 0.f, 0.f}, 0, 0, 0, 0x7f7f7f7f, 0, 0x7f7f7f7f);
                const u32x2 sw = *(const LAS u32x2*)(lst + kt2 * 16 + 4 * g);
                const int s0 = sw.x & 0xffff, s1 = sw.x >> 16, s2 = sw.y & 0xffff, s3 = sw.y >> 16; const int pos = kt2 * 16 + 4 * g;
                f32x4 lv; (void)pos;
                lv[0] = __builtin_fmaf(-slope2, (float)(t - s0), d[0]);
                lv[1] = __builtin_fmaf(-slope2, (float)(t - s1), d[1]);
                lv[2] = __builtin_fmaf(-slope2, (float)(t - s2), d[2]);
                lv[3] = __builtin_fmaf(-slope2, (float)(t - s3), d[3]);
                lg[kt2] = lv; }
        }
        if (cnt < 256) {
            asm volatile("" ::: "memory");
#pragma unroll
            for (int i = 0; i < 16; ++i)
#pragma unroll
                for (int r = 0; r < 4; ++r) lg[i][r] = (i * 16 + 4 * g + r < cnt) ? lg[i][r] : -INFINITY;
        }
#undef ATT_LOADK
        u32x4 vv[8][4];
#define ATT_LOADV(pp, buf) do { _Pragma("unroll") for (int i = 0; i < 4; ++i) { const int row = (lane >> 3) + 8 * i; const unsigned sidx = lst[32 * (pp) + row]; vv[buf][i] = *(const u32x4*)(kvb + (unsigned)((rowb32 + sidx) * 256u + 128u + (unsigned)(lane & 7) * 16u)); } } while (0)
        asm volatile("" ::: "memory");
#pragma unroll
        for (int pp = 0; pp < 6; ++pp) ATT_LOADV(pp, pp);
        float mx = -INFINITY;
#pragma unroll
        for (int i = 0; i < 16; ++i) mx = fmaxf(mx, fmaxf(fmaxf(lg[i][0], lg[i][1]), fmaxf(lg[i][2], lg[i][3])));
        mx = fmaxf(mx, shx(mx, 16, lane)); mx = fmaxf(mx, shx(mx, 32, lane));
        float sum = 0.f;
        const float c1 = scale * 1.4426950408889634f, nmx = -mx * c1 + 7.0f;
#pragma unroll
        for (int i = 0; i < 16; ++i) {
#pragma unroll
            for (int r = 0; r < 4; ++r) { const float e = __builtin_amdgcn_exp2f(__builtin_fmaf(lg[i][r], c1, nmx)); lg[i][r] = e; sum += e; } }
        sum += shx(sum, 16, lane); sum += shx(sum, 32, lane);
        const float inv = 1.0f / sum;
        long pf[8];
        {
#pragma unroll
          for (int pp = 0; pp < 8; ++pp) { const unsigned plo = pk4_fp8(lg[2 * pp][0], lg[2 * pp][1], lg[2 * pp][2], lg[2 * pp][3]), phi = pk4_fp8(lg[2 * pp + 1][0], lg[2 * pp + 1][1], lg[2 * pp + 1][2], lg[2 * pp + 1][3]);
              pf[pp] = (long)(((unsigned long long)phi << 32) | (unsigned long long)plo); } }
        asm volatile("" ::: "memory");
        ATT_LOADV(6, 6); ATT_LOADV(7, 7);
        f32x4 oacc[8];
#pragma unroll
        for (int dt = 0; dt < 8; ++dt) oacc[dt] = (f32x4){0.f, 0.f, 0.f, 0.f};
#pragma unroll
        for (int pp = 0; pp < 8; ++pp) {
            asm volatile("" ::: "memory");
#pragma unroll
            for (int i = 0; i < 4; ++i) { const int row = (lane >> 3) + 8 * i;
                *(LAS u32x4*)(VS + row * 128 + (((lane & 7) ^ (row & 7)) << 4)) = vv[pp][i]; }
            const int r8 = (lane & 15) >> 1, c8 = lane & 1; const int R8 = (r8 < 4) ? 4 * g + r8 : 12 + 4 * g + r8;
#pragma unroll
            for (int dt = 0; dt < 8; ++dt) {
                typedef int v2i_ __attribute__((ext_vector_type(2)));
                const v2i_ tv = __builtin_amdgcn_ds_read_tr8_b64_v2i32((LAS v2i_*)(VS + R8 * 128 + ((dt ^ (R8 & 7)) << 4) + 8 * c8));
                const long va = (long)(((unsigned long long)(unsigned)tv.y << 32) | (unsigned long long)(unsigned)tv.x);
                oacc[dt] = __builtin_amdgcn_mfma_f32_16x16x32_fp8_fp8(va, pf[pp], oacc[dt], 0, 0, 0);
            }
        }
#undef ATT_LOADV
#pragma unroll
        for (int dt = 0; dt < 8; ++dt) *(LAS unsigned*)(VS + n16 * 128 + ((dt ^ (n16 & 7)) << 4) + 4 * g) = pk4_fp8(oacc[dt][0] * inv, oacc[dt][1] * inv, oacc[dt][2] * inv, oacc[dt][3] * inv);
        { const int hr = lane >> 2, pb = (lane & 3) * 2;
          const u32x4 o0 = *(const LAS u32x4*)(VS + hr * 128 + ((pb ^ (hr & 7)) << 4)), o1 = *(const LAS u32x4*)(VS + hr * 128 + (((pb + 1) ^ (hr & 7)) << 4));
          unsigned char* yr = ws + WS_HB8 + (T0 + q) * D + lane * 32;
          if (!dry || o0.x == 0x12345678u) { *(u32x4*)yr = o0; *(u32x4*)(yr + 16) = o1; } }
    }
    __syncthreads();
}

namespace l1 {
constexpr int HH = 0, HL = 65792, LG = 131584, RI = LG + 2048, LC = RI + 2048, LB = LC + 64;
constexpr int HLD = 2056;
static_assert(LB + 64 <= LDS_BYTES - LDS_P, "ln1 lds");
}
__device__ __forceinline__ void phase_ln1(const Ctx& F0, int l) {
    PHASE_ENTER();
    using namespace l1;
    LAS unsigned char* P = F.P;
    LAS bf16_t* Hh = (LAS bf16_t*)(P + HH); LAS bf16_t* Hl = (LAS bf16_t*)(P + HL); LAS float* RED = (LAS float*)(P + HH);
    LAS float* Lg = (LAS float*)(P + LG); LAS int* Ri = (LAS int*)(P + RI); LAS int* Lc = (LAS int*)(P + LC); LAS int* Lb = (LAS int*)(P + LB);
    const bf16_t* PRE = (const bf16_t*)(ws + WS_PRE); bf16_t* HB = (bf16_t*)(ws + WS_HB);
    const bf16_t* WRH = (const bf16_t*)(ws + WS_WRH); const bf16_t* WRL = (const bf16_t*)(ws + WS_WRL);
    const float* gam = q_->in[I_LN1G] + l * D; const float* bet = q_->in[I_LN1B] + l * D;
    const float* bgrp = q_->in[I_BGRP] + l * 4; const float* bexp = q_->in[I_BEXP] + l * 16;
    unsigned* gcnt = ctl + CW_CNT + l * 1024;
    int* LIST = (int*)(ws + WS_LIST); float* WL = (float*)(ws + WS_WL); int* TOK = (int*)(ws + WS_TOK);
    const int tid = F.tid, lane = F.lane, w = F.wave, n16 = lane & 15, g = lane >> 4;
    if (tid < 16) Lc[tid] = 0;
    __syncthreads();
    const int rbase = F.vcu * 64;
    bf16x8 rbh0[8], rbh1[8];
    const int rpsrc = (4 * n16 + g) << 2; const int rlr = lane >> 2, rlp = lane & 3;
#pragma unroll
    for (int kk = 0; kk < 8; ++kk) { const int ks = 8 * w + kk; const size_t o0 = (size_t)rlr * 2048 + ks * 32 + 8 * rlp, o1 = (size_t)(16 + rlr) * 2048 + ks * 32 + 8 * rlp;
        rbh0[kk] = __builtin_bit_cast(bf16x8, pg8::lperm4(*(const u32x4*)(WRH + o0), rpsrc)); rbh1[kk] = __builtin_bit_cast(bf16x8, pg8::lperm4(*(const u32x4*)(WRH + o1), rpsrc)); }
    for (int it = 0; it < 4; ++it) {
#pragma unroll 1
        for (int rr = 0; rr < 2; ++rr) { const int r16 = 2 * w + rr; const size_t t = (size_t)rbase + it * 16 + r16;
            const u32x4* xr = (const u32x4*)(PRE + t * D) + lane;
            float v[4][8]; float s = 0.f;
#pragma unroll
            for (int j = 0; j < 4; ++j) { const u32x4 x = __builtin_nontemporal_load(xr + 64 * j);
                v[j][0] = lo16(x.x); v[j][1] = hi16(x.x); v[j][2] = lo16(x.y); v[j][3] = hi16(x.y); v[j][4] = lo16(x.z); v[j][5] = hi16(x.z); v[j][6] = lo16(x.w); v[j][7] = hi16(x.w);
#pragma unroll
                for (int e = 0; e < 8; ++e) s += v[j][e]; }
            const float mean = wave_sum(s, lane) * (1.0f / D); float s2 = 0.f;
#pragma unroll
            for (int j = 0; j < 4; ++j)
#pragma unroll
                for (int e = 0; e < 8; ++e) { v[j][e] -= mean; s2 += v[j][e] * v[j][e]; }
            const float rstd = 1.0f / sqrtf(wave_sum(s2, lane) * (1.0f / D) + LN_EPS);
#pragma unroll
            for (int j = 0; j < 4; ++j) { const int k0 = 8 * (lane + 64 * j);
                const f32x4 g0 = *(const f32x4*)(gam + k0), g1 = *(const f32x4*)(gam + k0 + 4), b0 = *(const f32x4*)(bet + k0), b1 = *(const f32x4*)(bet + k0 + 4);
                float y[8];
#pragma unroll
                for (int e = 0; e < 4; ++e) { y[e] = v[j][e] * rstd * g0[e] + b0[e]; y[4 + e] = v[j][4 + e] * rstd * g1[e] + b1[e]; }
                u32x4 hi; hi.x = pk2(y[0], y[1]); hi.y = pk2(y[2], y[3]); hi.z = pk2(y[4], y[5]); hi.w = pk2(y[6], y[7]);
                *((u32x4*)(HB + t * D) + lane + 64 * j) = hi;
                { u32x2 o8; o8.x = pk4_fp8(y[0], y[1], y[2], y[3]); o8.y = pk4_fp8(y[4], y[5], y[6], y[7]); *((u32x2*)(ws + WS_HB8 + t * D) + lane + 64 * j) = o8; }
                u32x4 lo; lo.x = pk2(y[0] - lo16(hi.x), y[1] - hi16(hi.x)); lo.y = pk2(y[2] - lo16(hi.y), y[3] - hi16(hi.y)); lo.z = pk2(y[4] - lo16(hi.z), y[5] - hi16(hi.z)); lo.w = pk2(y[6] - lo16(hi.w), y[7] - hi16(hi.w));
                *(LAS u32x4*)(Hh + r16 * HLD + k0) = hi; *(LAS u32x4*)(Hl + r16 * HLD + k0) = lo; }
        }
        __syncthreads();
        f32x4 d0 = {0.f, 0.f, 0.f, 0.f}, d1 = {0.f, 0.f, 0.f, 0.f};
#pragma unroll
        for (int kk = 0; kk < 8; ++kk) { const int ks = 8 * w + kk;
            const bf16x8 ah = *(const LAS bf16x8*)(Hh + n16 * HLD + ks * 32 + 8 * g), al = *(const LAS bf16x8*)(Hl + n16 * HLD + ks * 32 + 8 * g);
            const size_t o0 = (size_t)rlr * 2048 + ks * 32 + 8 * rlp, o1 = (size_t)(16 + rlr) * 2048 + ks * 32 + 8 * rlp;
            const bf16x8 bh0 = rbh0[kk], bh1 = rbh1[kk];
            const bf16x8 bl0 = __builtin_bit_cast(bf16x8, pg8::lperm4(*(const u32x4*)(WRL + o0), rpsrc)), bl1 = __builtin_bit_cast(bf16x8, pg8::lperm4(*(const u32x4*)(WRL + o1), rpsrc));
            d0 = __builtin_amdgcn_mfma_f32_16x16x32_bf16(ah, bh0, d0, 0, 0, 0); d0 = __builtin_amdgcn_mfma_f32_16x16x32_bf16(ah, bl0, d0, 0, 0, 0); d0 = __builtin_amdgcn_mfma_f32_16x16x32_bf16(al, bh0, d0, 0, 0, 0);
            d1 = __builtin_amdgcn_mfma_f32_16x16x32_bf16(ah, bh1, d1, 0, 0, 0); d1 = __builtin_amdgcn_mfma_f32_16x16x32_bf16(ah, bl1, d1, 0, 0, 0); d1 = __builtin_amdgcn_mfma_f32_16x16x32_bf16(al, bh1, d1, 0, 0, 0); }
        __syncthreads();
#pragma unroll
        for (int r = 0; r < 4; ++r) { RED[w * 512 + (4 * g + r) * 32 + n16] = d0[r]; RED[w * 512 + (4 * g + r) * 32 + 16 + n16] = d1[r]; }
        __syncthreads();
        { float s = 0.f;
#pragma unroll
          for (int k = 0; k < 8; ++k) s += RED[k * 512 + tid];
          Lg[tid] = s; }
        __syncthreads();
        if (tid < 16) { const LAS float* lgr = Lg + tid * 32;
            float g0 = lgr[0] + bgrp[0], g1 = lgr[1] + bgrp[1], g2 = lgr[2] + bgrp[2], g3 = lgr[3] + bgrp[3];
            int gi = 0; float gm = g0; if (g1 > gm) { gm = g1; gi = 1; } if (g2 > gm) { gm = g2; gi = 2; } if (g3 > gm) { gm = g3; gi = 3; }
            const float gp = 1.0f / (expf(g0 - gm) + expf(g1 - gm) + expf(g2 - gm) + expf(g3 - gm));
            const float e0 = lgr[4 + 4 * gi + 0] + bexp[4 * gi + 0], e1 = lgr[4 + 4 * gi + 1] + bexp[4 * gi + 1], e2 = lgr[4 + 4 * gi + 2] + bexp[4 * gi + 2], e3 = lgr[4 + 4 * gi + 3] + bexp[4 * gi + 3];
            int i0 = 0; float m0 = e0; if (e1 > m0) { m0 = e1; i0 = 1; } if (e2 > m0) { m0 = e2; i0 = 2; } if (e3 > m0) { m0 = e3; i0 = 3; }
            int i1 = -1; float m1 = -INFINITY;
            if (i0 != 0 && e0 > m1) { m1 = e0; i1 = 0; } if (i0 != 1 && e1 > m1) { m1 = e1; i1 = 1; } if (i0 != 2 && e2 > m1) { m1 = e2; i1 = 2; } if (i0 != 3 && e3 > m1) { m1 = e3; i1 = 3; }
            if (i1 < 0) i1 = (i0 == 0) ? 1 : 0;
            const float r1 = expf(m1 - m0); const float w0 = gp / (1.0f + r1), w1 = gp * r1 / (1.0f + r1);
            const int ex0 = 4 * gi + i0, ex1 = 4 * gi + i1;
            const int lp0 = atomicAdd((int*)(Lc + ex0), 1), lp1 = atomicAdd((int*)(Lc + ex1), 1);
            LAS int* ri = Ri + (it * 16 + tid) * 8; ri[0] = ex0; ri[1] = ex1; ri[2] = lp0; ri[3] = lp1; ri[4] = __float_as_int(w0); ri[5] = __float_as_int(w1); }
        __syncthreads();
    }
    if (tid < 16) Lb[tid] = (int)__hip_atomic_fetch_add(gcnt + tid * 16, (unsigned)Lc[tid], __ATOMIC_RELAXED, __HIP_MEMORY_SCOPE_AGENT);
    __syncthreads();
    if (tid < 64) { const LAS int* ri = Ri + tid * 8; const int t = rbase + tid; const int ex0 = ri[0], ex1 = ri[1]; const int p0 = Lb[ex0] + ri[2], p1 = Lb[ex1] + ri[3];
        LIST[ex0 * ECAP + p0] = t; LIST[ex1 * ECAP + p1] = t; WL[ex0 * ECAP + p0] = __int_as_float(ri[4]); WL[ex1 * ECAP + p1] = __int_as_float(ri[5]);
        TOK[t * 4 + 0] = ex0; TOK[t * 4 + 1] = p0; TOK[t * 4 + 2] = ex1; TOK[t * 4 + 3] = p1; }
    __syncthreads();
}

__device__ __forceinline__ void moe_tables(const Ctx& F0, int l) {
    PHASE_ENTER();
    if (F.tid == 0) { LAS int* tpre = (LAS int*)(F.lds + 64); LAS int* cn = (LAS int*)(F.lds + 192); unsigned* gcnt = ctl + CW_CNT + l * 1024; int acc = 0;
        for (int e = 0; e < 16; ++e) { const int c = (int)__hip_atomic_load(gcnt + e * 16, __ATOMIC_RELAXED, __HIP_MEMORY_SCOPE_AGENT); cn[e] = c; tpre[e] = acc; acc += (c + 255) >> 8; }
        tpre[16] = acc; }
    __syncthreads();
}

__device__ __forceinline__ void phase_ln2(const Ctx& F0, int l) {
    moe_tables(F0, l);
    PHASE_ENTER();
    const LAS int* tpre = (const LAS int*)(F.lds + 64);
    float* Hout = q_->out; bf16_t* HB = (bf16_t*)(ws + WS_HB); const bf16_t* Y = (const bf16_t*)(ws + WS_Y); const bf16_t* PLE = (const bf16_t*)(ws + WS_PLE);
    const int* TOK = (const int*)(ws + WS_TOK);
    const float* gam = PIN(I_LN2G) + l * D; const float* bet = PIN(I_LN2B) + l * D;
    const int lane = F.lane;
    const int gw = F.vcu * 8 + F.wave, NGW = F.G * 8;
    for (int t = gw; t < T; t += NGW) {
        const int e0 = TOK[t * 4 + 0], p0 = TOK[t * 4 + 1], e1 = TOK[t * 4 + 2], p1 = TOK[t * 4 + 3];
        const size_t s0 = (size_t)tpre[e0] * 256 + p0, s1 = (size_t)tpre[e1] * 256 + p1;
        const u32x4* hr = (const u32x4*)(HB + (size_t)t * D) + lane;
        const u32x4* y0 = (const u32x4*)(Y + s0 * D) + lane; const u32x4* y1 = (const u32x4*)(Y + s1 * D) + lane; const u32x4* pl = (const u32x4*)(PLE + (size_t)t * D) + lane;
        float v[4][8]; float s = 0.f;
#pragma unroll
        for (int j = 0; j < 4; ++j) { const u32x4 hv = __builtin_nontemporal_load(hr + 64 * j), a = __builtin_nontemporal_load(y0 + 64 * j), b2 = __builtin_nontemporal_load(y1 + 64 * j), c = __builtin_nontemporal_load(pl + 64 * j);
            v[j][0] = DN_ALPHA * lo16(hv.x) + lo16(a.x) + lo16(b2.x) + lo16(c.x); v[j][1] = DN_ALPHA * hi16(hv.x) + hi16(a.x) + hi16(b2.x) + hi16(c.x);
            v[j][2] = DN_ALPHA * lo16(hv.y) + lo16(a.y) + lo16(b2.y) + lo16(c.y); v[j][3] = DN_ALPHA * hi16(hv.y) + hi16(a.y) + hi16(b2.y) + hi16(c.y);
            v[j][4] = DN_ALPHA * lo16(hv.z) + lo16(a.z) + lo16(b2.z) + lo16(c.z); v[j][5] = DN_ALPHA * hi16(hv.z) + hi16(a.z) + hi16(b2.z) + hi16(c.z);
            v[j][6] = DN_ALPHA * lo16(hv.w) + lo16(a.w) + lo16(b2.w) + lo16(c.w); v[j][7] = DN_ALPHA * hi16(hv.w) + hi16(a.w) + hi16(b2.w) + hi16(c.w);
#pragma unroll
            for (int e = 0; e < 8; ++e) s += v[j][e]; }
        const float mean = wave_sum(s, lane) * (1.0f / D); float s2 = 0.f;
#pragma unroll
        for (int j = 0; j < 4; ++j)
#pragma unroll
            for (int e = 0; e < 8; ++e) { v[j][e] -= mean; s2 += v[j][e] * v[j][e]; }
        const float rstd = 1.0f / sqrtf(wave_sum(s2, lane) * (1.0f / D) + LN_EPS);
#pragma unroll
        for (int j = 0; j < 4; ++j) { const int k0 = 8 * (lane + 64 * j);
            const f32x4 g0 = *(const f32x4*)(gam + k0), g1 = *(const f32x4*)(gam + k0 + 4), b0 = *(const f32x4*)(bet + k0), b1 = *(const f32x4*)(bet + k0 + 4);
            f32x4 ya, yb;
#pragma unroll
            for (int e = 0; e < 4; ++e) { ya[e] = v[j][e] * rstd * g0[e] + b0[e]; yb[e] = v[j][4 + e] * rstd * g1[e] + b1[e]; }
#ifdef FP8_SELFTEST
            if (l == 1) { const float fct = ((const float*)ctl)[CW_CNT + 4000]; ya = ya * fct; yb = yb * fct; }
#endif
            if (l == 1) { *(f32x4*)(Hout + (size_t)t * D + k0) = ya; *(f32x4*)(Hout + (size_t)t * D + k0 + 4) = yb; }
            else { u32x4 hi; hi.x = pk2(ya[0], ya[1]); hi.y = pk2(ya[2], ya[3]); hi.z = pk2(yb[0], yb[1]); hi.w = pk2(yb[2], yb[3]); *((u32x4*)(HB + (size_t)t * D) + lane + 64 * j) = hi;
                u32x2 o8; o8.x = pk4_fp8(ya[0], ya[1], ya[2], ya[3]); o8.y = pk4_fp8(yb[0], yb[1], yb[2], yb[3]); *((u32x2*)(ws + WS_HB8 + (size_t)t * D) + lane + 64 * j) = o8;
                } }
    }
}

#define TOKTAB(F) ((LAS unsigned*)((F).lds + LDS_P + 131072))
__device__ __forceinline__ void phase_inproj(const Ctx& F0) {
    PHASE_ENTER();
    { typedef pg8::DenseSched<T, LDP, D / 2, D / 2, 3, 2> Sch; Sch S; S.init(F.G, (int)blockIdx.x, ws + WS_HB8, ws + WS_WIN8);
      pg8::EpiStoreBf16NT E{(bf16_t*)(ws + WS_PROJ), LDP};
      pg8::gemm_phase<pg8::EpiStoreBf16NT, Sch, false, true, D / 2, D / 2, D / 2, true>(F.P, F.tid, TOKTAB(F), S, E); }
    { typedef pg8::DenseSched<T, LDP, D, D, 4, 0> Sch; Sch S; S.init(F.G, (int)blockIdx.x, ws + WS_HB, ws + WS_WIN);
      pg8::EpiStoreBf16NT E{(bf16_t*)(ws + WS_PROJ), LDP};
      pg8::gemm_phase<pg8::EpiStoreBf16NT, Sch, false, true, D, D, D>(F.P, F.tid, TOKTAB(F), S, E); }
}
__device__ __forceinline__ void phase_mix_a(const Ctx& F0) {
    PHASE_ENTER();
    bf16_t* PROJ = (bf16_t*)(ws + WS_PROJ);
    typedef pg8::DenseSched<T, D, D / 2, D / 2> Sch; Sch S; S.init(F.G, (int)blockIdx.x, ws + WS_HB8, ws + WS_WPA8);
    pg8::EpiGate<false> E{(bf16_t*)(ws + WS_MIX), D, PROJ + C_GA, LDP, nullptr, 0};
    pg8::gemm_phase<pg8::EpiGate<false>, Sch, false, true, D / 2, D / 2, D / 2, true>(F.P, F.tid, TOKTAB(F), S, E);
}
__device__ __forceinline__ void phase_mix_m(const Ctx& F0) {
    PHASE_ENTER();
    bf16_t* PROJ = (bf16_t*)(ws + WS_PROJ);
    typedef pg8::DenseSched<T, D, D / 2, D / 2> Sch; Sch S; S.init(F.G, (int)blockIdx.x, ws + WS_YM8, ws + WS_WPM8);
    pg8::EpiGate<true> E{(bf16_t*)(ws + WS_MIX), D, PROJ + C_GM, LDP, (unsigned char*)(PROJ + C_AQ), LDP * 2};
    pg8::gemm_phase<pg8::EpiGate<true>, Sch, false, true, D / 2, D / 2, D / 2, true, (int)0x80808080, 0x79797979>(F.P, F.tid, TOKTAB(F), S, E);
}
__device__ __forceinline__ void phase_out(const Ctx& F0, int l) {
    PHASE_ENTER();
    typedef pg8::DenseSched<T, D, LDP, D / 2> Sch; Sch S; S.init(F.G, (int)blockIdx.x, ws + WS_PROJ, ws + WS_WOUT8);
    pg8::EpiResBf16 E{(bf16_t*)(ws + WS_PRE), (const bf16_t*)(ws + WS_HB), DN_ALPHA, D};
    pg8::gemm_phase<pg8::EpiResBf16, Sch, false, true, D / 2, LDP, D / 2, true>(F.P, F.tid, TOKTAB(F), S, E);
}
__device__ __forceinline__ void phase_moe_up(const Ctx& F0, int l) {
    moe_tables(F0, l);
    PHASE_ENTER();
    pg8::MoeSched S; S.tpre = (const LAS int*)(F.lds + 64); S.cnt = (const LAS int*)(F.lds + 192); S.NT = 4; S.G = F.G; S.c = (int)blockIdx.x; S.mode = 0;
    S.Abase = (const char*)(ws + WS_HB8); S.Bbase = (const char*)(ws + WS_WGU8); S.list = (const int*)(ws + WS_LIST); S.bshift = 1;
    pg8::EpiSwiglu E{(unsigned char*)(ws + WS_HMID), (const float*)(ws + WS_WL)};
    pg8::gemm_phase<pg8::EpiSwiglu, pg8::MoeSched, true, true, D / 2, D / 2, D / 2, true>(F.P, F.tid, TOKTAB(F), S, E);
}
__device__ __forceinline__ void phase_ple(const Ctx& F0) {
    PHASE_ENTER();
    typedef pg8::DenseSched<T, D, 256, 256> Sch; Sch S; S.init(F.G, (int)blockIdx.x, ws + WS_PB, ws + WS_WPLE);
    pg8::EpiStoreBf16 E{(bf16_t*)(ws + WS_PLE), D};
    pg8::gemm_phase<pg8::EpiStoreBf16, Sch, false, true, 256, 256, 256>(F.P, F.tid, TOKTAB(F), S, E);
}
__device__ __forceinline__ void phase_plegate(const Ctx& F0) {
    PHASE_ENTER();
    typedef pg8::DenseSched<T, D, D / 2, D / 2> Sch; Sch S; S.init(F.G, (int)blockIdx.x, ws + WS_HB8, ws + WS_WPG8);
    pg8::EpiPleGate E{(bf16_t*)(ws + WS_PLE), D};
    pg8::gemm_phase<pg8::EpiPleGate, Sch, false, true, D / 2, D / 2, D / 2, true>(F.P, F.tid, TOKTAB(F), S, E);
}
__device__ __forceinline__ void phase_moe_down(const Ctx& F0, int l) {
    moe_tables(F0, l);
    PHASE_ENTER();
    pg8::MoeSched S; S.tpre = (const LAS int*)(F.lds + 64); S.cnt = (const LAS int*)(F.lds + 192); S.NT = 8; S.G = F.G; S.c = (int)blockIdx.x; S.mode = 1; S.bshift = 1;
    S.Abase = (const char*)(ws + WS_HMID); S.Bbase = (const char*)(ws + WS_WD8); S.list = nullptr;
    pg8::EpiStoreBf16NT E{(bf16_t*)(ws + WS_Y), D};
    pg8::gemm_phase<pg8::EpiStoreBf16NT, pg8::MoeSched, false, true, 256, 256, 256, true, 0x7b7b7b7b, 0x79797979>(F.P, F.tid, TOKTAB(F), S, E);
}
__device__ __forceinline__ void phase_mixers(const Ctx& F0, int l, int dry, int conv) {
    const int b = F0.vcu >> 5, j = F0.vcu & 31, slot = F0.vcu % 5;
#pragma unroll 1
    for (int st = 0; st < 5; ++st) {
        if (conv && st == slot) { phase_convert(F0, l, 1); __syncthreads(); }
        if (st == 0) mlstm_unit(F0, l, F0.vcu, dry);
        else { const int ui = st - 1; const int qt = (ui == 0) ? j : (ui == 1) ? 63 - j : (ui == 2) ? 64 + j : 127 - j; att_unit(F0, b, qt, dry, 0); }
    }
}
__device__ __forceinline__ void grid_seam(const Ctx& F0) {
    PHASE_ENTER();
    XcdBarrier bar; bar.bar = ctl + CW_BAR + q_->li * XCD_BAR_WORDS; bar.x = xb_xcc_id(); bar.st = (volatile LAS unsigned*)(F.lds + 16);
    xcd_barrier(bar, F.tid);
}

#ifndef PH_MASK
#define PH_MASK 0x3ff
#endif
__global__ void __launch_bounds__(512, 2) mega_fwd(Params p) {
    extern __shared__ __attribute__((aligned(16))) unsigned char lds_raw[];
    Ctx F;
    F.lds = (LAS unsigned char*)lds_raw; F.P = F.lds + LDS_P;
    F.tid = threadIdx.x; F.lane = F.tid & 63; F.wave = __builtin_amdgcn_readfirstlane(F.tid >> 6);
    F.G = gridDim.x; { const int bx = blockIdx.x; F.vcu = (F.G % 8 == 0) ? (bx % 8) * (F.G / 8) + bx / 8 : bx; }
    F.kp = (const CAS Params*)__builtin_amdgcn_kernarg_segment_ptr();
    for (int u = F.tid; u < LDS_P / 4; u += 512) ((LAS unsigned*)F.lds)[u] = 0u;
    __syncthreads();
    (void)xcd_barrier_post((unsigned*)p.ws + CW_BAR + p.li * XCD_BAR_WORDS, (volatile LAS unsigned*)(F.lds + 16), F.tid);

#ifdef FP8_SELFTEST
    if (blockIdx.x == 0 && F.wave == 0) {
        typedef int v8i_ __attribute__((ext_vector_type(8)));
        const int lane = F.lane, gq = lane >> 4;
        float factor = 1.0f;
        {
            v8i_ a, b; for (int i = 0; i < 8; ++i) { a[i] = 0x38383838; b[i] = 0x38383838; }
            f32x4 d = {0.f, 0.f, 0.f, 0.f}; const int s1 = 0x7f7f7f7f;
            asm volatile("v_mfma_scale_f32_16x16x128_f8f6f4 %0, %1, %2, %0, %3, %4 op_sel_hi:[0,0,0]\n\ts_nop 15\n\ts_nop 15" : "+v"(d) : "v"(a), "v"(b), "v"(s1), "v"(s1));
            if (!(d[0] == 128.f && d[3] == 128.f)) factor += 0.1f;
            f32x4 d2 = {0.f, 0.f, 0.f, 0.f}; const int s2 = 0x79797979;
            asm volatile("v_mfma_scale_f32_16x16x128_f8f6f4 %0, %1, %2, %0, %3, %4 op_sel_hi:[0,0,0]\n\ts_nop 15\n\ts_nop 15" : "+v"(d2) : "v"(a), "v"(b), "v"(s2), "v"(s1));
            if (!(d2[0] == 2.f && d2[3] == 2.f)) factor += 0.2f; }
        {
            v8i_ a, b; for (int i = 0; i < 8; ++i) { a[i] = 0; b[i] = 0; }
            if (gq == 1) { a[1] = 0x00003800; b[1] = 0x00003800; }
            f32x4 d = {0.f, 0.f, 0.f, 0.f}; const int s1 = 0x7f7f7f7f;
            asm volatile("v_mfma_scale_f32_16x16x128_f8f6f4 %0, %1, %2, %0, %3, %4 op_sel_hi:[0,0,0]\n\ts_nop 15\n\ts_nop 15" : "+v"(d) : "v"(a), "v"(b), "v"(s1), "v"(s1));
            if (!(d[0] == 1.f && d[1] == 1.f && d[2] == 1.f && d[3] == 1.f)) factor += 0.4f; }
        {
            const unsigned wv = pk4_fp8(1.0f, 0.5f, 1.5f, 448.f);
            if (wv != 0x7e3c3038u) factor += 0.8f; }
        if (lane == 0) ((float*)p.ws)[CW_CNT + 4000] = factor;
    }
#endif
    const int lo = p.ph_lo, hi = p.ph_hi;
#define IN(k) (((PH_MASK >> ((k) % 10)) & 1) && lo <= (k) && (k) < hi)
#define SEAM(k) do { if ((k) + 1 < hi) grid_seam(F); } while (0)
#pragma unroll 1
    for (int l = 0; l < 2; ++l) {
        const int pb = l * 10;
        if (IN(pb + 0)) {
#ifdef DUP_CONV
            phase_convert(F, l, 0);
#endif
            phase_convert(F, l, 0); SEAM(pb + 0); }
        if (IN(pb + 1)) {
#ifdef DUP_INPROJ
            phase_inproj(F);
#endif
            phase_inproj(F); SEAM(pb + 1); }
        if (IN(pb + 2)) { phase_kv(F, l); SEAM(pb + 2); }
        if (IN(pb + 3)) {
#ifdef DUP_MIXERS
            phase_mixers(F, l, 1 + (p.pad & 1), 0);
#endif
#ifdef DUP_ML
            mlstm_unit(F, l, F.vcu, 1 + (p.pad & 1));
#endif
#ifdef DUP_AT
            { const int b_ = F.vcu >> 5, j_ = F.vcu & 31;
#pragma unroll 1
              for (int ui = 0; ui < 4; ++ui) { const int qt = (ui == 0) ? j_ : (ui == 1) ? 63 - j_ : (ui == 2) ? 64 + j_ : 127 - j_; att_unit(F, b_, qt, 1 + (p.pad & 1), DUP_AT + (p.pad & 1)); } }
#endif
            phase_mixers(F, l, p.pad, 1); SEAM(pb + 3); }
        if (IN(pb + 4)) {
#ifdef DUP_MIX
            phase_mix_a(F); phase_mix_m(F);
#endif
            phase_mix_a(F); phase_mix_m(F); SEAM(pb + 4); }
        if (IN(pb + 5)) {
#ifdef DUP_OUT
            phase_out(F, l);
#endif
            phase_out(F, l); SEAM(pb + 5); }
        if (IN(pb + 6)) { phase_ln1(F, l); SEAM(pb + 6); }
        if (IN(pb + 7)) {
#ifdef DUP_MOEUP
            phase_moe_up(F, l);
#endif
#ifdef DUP_PLE
            phase_ple(F); phase_plegate(F);
#endif
#ifndef NO_MOEUP
            phase_moe_up(F, l);
#endif
#ifndef NO_PLE
            phase_ple(F);
#endif
#ifndef NO_PLEG
            phase_plegate(F);
#endif
            SEAM(pb + 7); }
        if (IN(pb + 8)) {
#ifdef DUP_DOWN
            phase_moe_down(F, l);
#endif
            phase_moe_down(F, l); SEAM(pb + 8); }
        if (IN(pb + 9)) { phase_ln2(F, l); if (l == 1) SEAM(pb + 9); }
    }
#undef IN
#undef SEAM
}

extern "C" void kernel_launch(void* const* d_in, const int* in_sizes, int n_in, void* d_out, int out_size, void* d_ws, size_t ws_size, hipStream_t stream) {
    static int grid = 0;
    if (grid == 0) {
        if (n_in != 23 || out_size != T * D || ws_size < WS_END) { fprintf(stderr, "kernel_launch: unexpected shapes (n_in %d, out %d, ws %zu, need %zu)\n", n_in, out_size, ws_size, (size_t)WS_END); grid = -1; return; }
        int dev = 0, cus = 0, per_cu = 0;
        if (hipGetDevice(&dev) != hipSuccess || hipDeviceGetAttribute(&cus, hipDeviceAttributeMultiprocessorCount, dev) != hipSuccess) { grid = -1; return; }
        if (hipFuncSetAttribute((const void*)mega_fwd, hipFuncAttributeMaxDynamicSharedMemorySize, LDS_BYTES) != hipSuccess) { fprintf(stderr, "kernel_launch: hipFuncSetAttribute failed\n"); grid = -1; return; }
        if (hipOccupancyMaxActiveBlocksPerMultiprocessor(&per_cu, (const void*)mega_fwd, 512, LDS_BYTES) != hipSuccess || per_cu < 1) fprintf(stderr, "kernel_launch: occupancy query says %d\n", per_cu);
        (void)hipGetLastError();
        grid = cus;
        if (grid != 256) fprintf(stderr, "kernel_launch: %d CUs (built for 256)\n", grid);
    }
    if (grid < 0) return;
    if (hipMemsetAsync((char*)d_ws + WS_CTL, 0, CTL_BYTES, stream) != hipSuccess) return;
    Params a{};
    for (int i = 0; i < 23; ++i) a.in[i] = (const float*)d_in[i];
    a.out = (float*)d_out; a.ws = (unsigned char*)d_ws;
    constexpr int NPH = 20;
    for (int li = 0; li < MK_N_LAUNCHES; ++li) {
        a.ph_lo = li * NPH / MK_N_LAUNCHES; a.ph_hi = (li + 1) * NPH / MK_N_LAUNCHES; a.li = li; a.pad = 0;
        hipLaunchKernelGGL(mega_fwd, dim3(grid), dim3(512), LDS_BYTES, stream, a);
    }
}
```
